# Optimizing an MI355X kernel written in HIP

```python
import jax, jax.numpy as jnp
from jax import lax
import numpy as np

D_MODEL = 1024
BATCH = 1
SEQ = 16384
DEPTH = 4

GRID_W = 64
CTX_LEN = 256
HEAD_DIM = 64
EPS = 1e-6
A_HEADS = 8
A_KV_HEADS = 2
A_GROUP = A_HEADS // A_KV_HEADS
A_Q = A_HEADS * HEAD_DIM
A_KV = A_KV_HEADS * HEAD_DIM
A_IN = A_Q + 2 * A_KV
Q_BLOCK = 128
ROPE_THETA = 10000.0
ROPE_FREQS = HEAD_DIM // 4
B_GROUPS = 8
B_CH = 64
B_WIDTH = B_GROUPS * B_CH
CHUNK = 128
C_HEADS = 8
C_W = C_HEADS * HEAD_DIM
NA_MAX_ROWS = 8
NA_COLS = 16
D_CH = 512
CONV_W = 31
MIX_WIDTH = A_Q + B_WIDTH
EVEN_IN = A_IN + 2 * B_WIDTH
ODD_IN = 3 * C_W + 2 * D_CH
N_EVEN = (DEPTH + 1) // 2
N_ODD = DEPTH // 2
N_EXPERTS = 16
N_GROUPS = 4
EXPERTS_PER_GROUP = N_EXPERTS // N_GROUPS
TOPK_GROUPS = 1
TOP_K = 2
D_EXPERT = 512
MOE_BLOCK = 256

kernel_name = 'hybrid_flow_backbone'


def rms_norm(x, g):
    xf = x.astype(jnp.float32)
    y = xf * lax.rsqrt(jnp.mean(xf * xf, axis=-1, keepdims=True) + EPS)
    return (y * g.astype(jnp.float32)).astype(x.dtype)


def layer_norm(x, g, b):
    xf = x.astype(jnp.float32)
    mu = jnp.mean(xf, axis=-1, keepdims=True)
    var = jnp.mean(jnp.square(xf - mu), axis=-1, keepdims=True)
    y = (xf - mu) * lax.rsqrt(var + EPS)
    return (y * g.astype(jnp.float32) + b.astype(jnp.float32)).astype(x.dtype)


def axial_rope_tables(n_tok, dtype):
    t = jnp.arange(n_tok, dtype=jnp.int32)
    pos = jnp.stack([t // GRID_W, t % GRID_W], axis=-1).astype(jnp.float32)
    inv = ROPE_THETA ** (-jnp.arange(ROPE_FREQS, dtype=jnp.float32) / ROPE_FREQS)
    ang = pos[:, :, None] * inv
    return jnp.cos(ang).astype(dtype), jnp.sin(ang).astype(dtype)


def apply_axial_rope(x, cos, sin):
    b, s, h, _ = x.shape
    xs = x.reshape(b, s, h, 2, 2, ROPE_FREQS)
    x1, x2 = xs[..., 0, :], xs[..., 1, :]
    cs, sn = cos[None, :, None], sin[None, :, None]
    out = jnp.stack([x1 * cs - x2 * sn, x2 * cs + x1 * sn], axis=-2)
    return out.reshape(x.shape)


def dense_gqa(q, k, v):
    s = jnp.einsum('bqkgd,bskd->bkgqs', q, k, preferred_element_type=jnp.float32) * (HEAD_DIM ** -0.5)
    p = jax.nn.softmax(s, axis=-1).astype(v.dtype)
    return jnp.einsum('bkgqs,bskd->bqkgd', p, v)


def blocked_gqa(q, k, v):
    b, s = q.shape[:2]
    nb = s // Q_BLOCK
    qb = jnp.moveaxis(q.reshape(b, nb, Q_BLOCK, *q.shape[2:]), 1, 0)
    o = lax.map(lambda qi: dense_gqa(qi, k, v), qb)
    return jnp.moveaxis(o, 0, 1).reshape(q.shape)


def mixer_a(p_lat, p_ctx, q_g, k_g, need_ctx):
    b, s, _ = p_lat.shape

    def heads(p):
        lead = p.shape[:2]
        q = rms_norm(p[..., :A_Q].reshape(*lead, A_HEADS, HEAD_DIM), q_g)
        k = rms_norm(p[..., A_Q:A_Q + A_KV].reshape(*lead, A_KV_HEADS, HEAD_DIM), k_g)
        v = p[..., A_Q + A_KV:A_IN].reshape(*lead, A_KV_HEADS, HEAD_DIM)
        return q, k, v

    ql, kl, vl = heads(p_lat)
    qc, kc, vc = heads(p_ctx)
    cos, sin = axial_rope_tables(s, ql.dtype)
    ql = apply_axial_rope(ql, cos, sin)
    kl = apply_axial_rope(kl, cos, sin)
    k_all = jnp.concatenate([kc, kl], axis=1)
    v_all = jnp.concatenate([vc, vl], axis=1)
    o_lat = blocked_gqa(ql.reshape(b, s, A_KV_HEADS, A_GROUP, HEAD_DIM), k_all, v_all).reshape(b, s, A_Q)
    if not need_ctx:
        return o_lat, None
    o_ctx = dense_gqa(qc.reshape(b, -1, A_KV_HEADS, A_GROUP, HEAD_DIM), kc, vc).reshape(b, -1, A_Q)
    return o_lat, o_ctx


def chunk_spatial_gate(p, v_g, ws, bs):
    b, n_tok, _ = p.shape
    n = n_tok // CHUNK
    z = jax.nn.gelu(p)
    u, v = z[..., :B_WIDTH], z[..., B_WIDTH:]
    v = rms_norm(v.reshape(b, n, CHUNK, B_GROUPS, B_CH), v_g.reshape(B_GROUPS, B_CH))
    mixed = jnp.einsum('gts,bnsgc->bntgc', ws, v) + bs.T[:, :, None]
    return u * mixed.reshape(b, n_tok, B_WIDTH)


def neighbourhood_attention(q, k, v, k_ctx, v_ctx, rpb):
    b, s, h, dh = q.shape
    rows = s // GRID_W
    wh = min(NA_MAX_ROWS, rows)
    n_loc = wh * NA_COLS
    qg, kg, vg = (t.reshape(b, rows, GRID_W, h, dh) for t in (q, k, v))
    r = jnp.arange(rows, dtype=jnp.int32)
    row_idx = jnp.clip(r - wh // 2, 0, rows - wh)[:, None] + jnp.arange(wh, dtype=jnp.int32)[None, :]
    cc = jnp.arange(GRID_W, dtype=jnp.int32)
    col_idx = jnp.clip(cc - NA_COLS // 2, 0, GRID_W - NA_COLS)[:, None] + jnp.arange(NA_COLS, dtype=jnp.int32)[None, :]
    rpb_cols = rpb.astype(jnp.float32)[:, :, col_idx - cc[:, None] + NA_COLS - 1]
    scale = HEAD_DIM ** -0.5

    def row_block(args):
        qr, ridx, ri = args
        kr = jnp.take(kg, ridx, axis=1)[:, :, col_idx]
        vr = jnp.take(vg, ridx, axis=1)[:, :, col_idx]
        bias = jnp.transpose(rpb_cols[:, ridx - ri + NA_MAX_ROWS - 1], (0, 2, 1, 3))
        s_loc = jnp.einsum('bchd,bicjhd->bhcij', qr, kr, preferred_element_type=jnp.float32) * scale + bias
        s_ctx = jnp.einsum('bchd,bshd->bhcs', qr, k_ctx, preferred_element_type=jnp.float32) * scale
        sc = jnp.concatenate([s_loc.reshape(b, h, GRID_W, n_loc), s_ctx], axis=-1)
        p = jax.nn.softmax(sc, axis=-1).astype(v.dtype)
        p_loc = p[..., :n_loc].reshape(b, h, GRID_W, wh, NA_COLS)
        return jnp.einsum('bhcij,bicjhd->bchd', p_loc, vr) + jnp.einsum('bhcs,bshd->bchd', p[..., n_loc:], v_ctx)

    o = lax.map(row_block, (jnp.moveaxis(qg, 1, 0), row_idx, r))
    return jnp.moveaxis(o, 0, 1).reshape(b, s, h * dh)


def mixer_c(p_lat, p_ctx, q_g, k_g, rpb, need_ctx):
    def heads(p):
        lead = p.shape[:2]
        q = rms_norm(p[..., :C_W].reshape(*lead, C_HEADS, HEAD_DIM), q_g)
        k = rms_norm(p[..., C_W:2 * C_W].reshape(*lead, C_HEADS, HEAD_DIM), k_g)
        v = p[..., 2 * C_W:3 * C_W].reshape(*lead, C_HEADS, HEAD_DIM)
        return q, k, v

    ql, kl, vl = heads(p_lat)
    qc, kc, vc = heads(p_ctx)
    o_lat = neighbourhood_attention(ql, kl, vl, kc, vc, rpb)
    if not need_ctx:
        return o_lat, None
    b = qc.shape[0]
    o_ctx = dense_gqa(qc[:, :, :, None], kc, vc).reshape(b, -1, C_W)
    return o_lat, o_ctx


def conformer_conv(p, dw, dw_b, ln_g, ln_b):
    a, g = p[..., :D_CH], p[..., D_CH:]
    y = a * jax.nn.sigmoid(g)
    y = lax.conv_general_dilated(y, dw[:, None, :], window_strides=(1,),
                                 padding=[(CONV_W // 2, CONV_W // 2)],
                                 dimension_numbers=('NWC', 'WIO', 'NWC'),
                                 feature_group_count=D_CH) + dw_b
    return jax.nn.silu(layer_norm(y, ln_g, ln_b))


def moe_ffn(h, router_w, router_b, w_gate, w_up, w_down):
    t, d = h.shape
    aff = jax.nn.sigmoid(jnp.dot(h, router_w, preferred_element_type=jnp.float32))
    sel = aff + router_b.astype(jnp.float32)
    gscore = lax.top_k(sel.reshape(t, N_GROUPS, EXPERTS_PER_GROUP), 2)[0].sum(-1)
    _, gtop = lax.top_k(gscore, TOPK_GROUPS)
    gmask = jnp.any(gtop[:, :, None] == jnp.arange(N_GROUPS)[None, None, :], axis=1)
    emask = jnp.repeat(gmask, EXPERTS_PER_GROUP, axis=1)
    _, eidx = lax.top_k(jnp.where(emask, sel, -jnp.inf), TOP_K)
    w = jnp.take_along_axis(aff, eidx, axis=1)
    w = w / jnp.sum(w, axis=-1, keepdims=True)
    n_assign = t * TOP_K
    e_flat = eidx.reshape(n_assign)
    tok = jnp.repeat(jnp.arange(t, dtype=jnp.int32), TOP_K)
    gate = w.reshape(n_assign).astype(h.dtype)
    order = jnp.argsort(e_flat)
    e_s, tok_s, gate_s = e_flat[order], tok[order], gate[order]
    counts = jnp.bincount(e_flat, length=N_EXPERTS)
    start = jnp.cumsum(counts) - counts
    pcounts = (counts + MOE_BLOCK - 1) // MOE_BLOCK * MOE_BLOCK
    pend = jnp.cumsum(pcounts)
    pstart = pend - pcounts
    dest = pstart[e_s] + jnp.arange(n_assign, dtype=jnp.int32) - start[e_s]
    n_blocks = -(-n_assign // MOE_BLOCK) + N_EXPERTS
    buf = jnp.zeros((n_blocks * MOE_BLOCK, d), h.dtype).at[dest].set(h[tok_s])
    blk_e = jnp.minimum(jnp.searchsorted(pend, jnp.arange(n_blocks, dtype=jnp.int32) * MOE_BLOCK, side='right'), N_EXPERTS - 1)

    def expert_block(args):
        xb, e = args
        return (jax.nn.silu(xb @ w_gate[e]) * (xb @ w_up[e])) @ w_down[e]

    y = lax.map(expert_block, (buf.reshape(n_blocks, MOE_BLOCK, d), blk_e)).reshape(-1, d)
    return jnp.zeros_like(h).at[tok_s].add(y[dest] * gate_s[:, None])


def setup_inputs(seed: int = 0) -> dict:
    key = jax.random.key(seed)
    ks = jax.random.split(key, 32)
    f32 = jnp.float32

    def nrm(k, shape, scale):
        return jax.random.normal(k, shape, f32) * scale

    def gain(k, shape):
        return 1.0 + nrm(k, shape, 0.05)

    return {
        'x': nrm(ks[0], (BATCH, SEQ, D_MODEL), 1.0),
        'c': nrm(ks[1], (BATCH, D_MODEL), 1.0),
        'ctx': nrm(ks[2], (BATCH, CTX_LEN, D_MODEL), 1.0),
        'c_ctx': nrm(ks[3], (D_MODEL,), 1.0),
        'router_w': nrm(ks[4], (D_MODEL, N_EXPERTS), D_MODEL ** -0.5),
        'router_b': nrm(ks[5], (N_EXPERTS,), 0.01),
        'ada_w': nrm(ks[6], (DEPTH, D_MODEL, 6 * D_MODEL), 0.5 * D_MODEL ** -0.5),
        'ada_b': nrm(ks[7], (DEPTH, 6 * D_MODEL), 0.02),
        'norm1_g': gain(ks[8], (DEPTH, D_MODEL)),
        'norm2_g': gain(ks[9], (DEPTH, D_MODEL)),
        'ev_w_in': nrm(ks[10], (N_EVEN, D_MODEL, EVEN_IN), D_MODEL ** -0.5),
        'ev_w_out': nrm(ks[11], (N_EVEN, MIX_WIDTH, D_MODEL), MIX_WIDTH ** -0.5),
        'a_q_norm': gain(ks[12], (N_EVEN, HEAD_DIM)),
        'a_k_norm': gain(ks[13], (N_EVEN, HEAD_DIM)),
        'b_v_norm': gain(ks[14], (N_EVEN, B_WIDTH)),
        'b_ws': nrm(ks[15], (N_EVEN, B_GROUPS, CHUNK, CHUNK), CHUNK ** -0.5),
        'b_bs': nrm(ks[16], (N_EVEN, B_GROUPS, CHUNK), 0.02),
        'od_w_in': nrm(ks[17], (N_ODD, D_MODEL, ODD_IN), D_MODEL ** -0.5),
        'od_w_out': nrm(ks[18], (N_ODD, MIX_WIDTH, D_MODEL), MIX_WIDTH ** -0.5),
        'c_q_norm': gain(ks[19], (N_ODD, HEAD_DIM)),
        'c_k_norm': gain(ks[20], (N_ODD, HEAD_DIM)),
        'c_rpb': nrm(ks[21], (N_ODD, C_HEADS, 2 * NA_MAX_ROWS - 1, 2 * NA_COLS - 1), 0.1),
        'd_dw': nrm(ks[22], (N_ODD, CONV_W, D_CH), CONV_W ** -0.5),
        'd_dw_b': nrm(ks[23], (N_ODD, D_CH), 0.02),
        'd_ln_g': gain(ks[24], (N_ODD, D_CH)),
        'd_ln_b': nrm(ks[25], (N_ODD, D_CH), 0.02),
        'moe_w_gate': nrm(ks[26], (DEPTH, N_EXPERTS, D_MODEL, D_EXPERT), D_MODEL ** -0.5),
        'moe_w_up': nrm(ks[27], (DEPTH, N_EXPERTS, D_MODEL, D_EXPERT), D_MODEL ** -0.5),
        'moe_w_down': nrm(ks[28], (DEPTH, N_EXPERTS, D_EXPERT, D_MODEL), D_EXPERT ** -0.5),
    }


def reference(x, c, ctx, c_ctx, router_w, router_b, ada_w, ada_b, norm1_g, norm2_g,
              ev_w_in, ev_w_out, a_q_norm, a_k_norm, b_v_norm, b_ws, b_bs,
              od_w_in, od_w_out, c_q_norm, c_k_norm, c_rpb, d_dw, d_dw_b, d_ln_g, d_ln_b,
              moe_w_gate, moe_w_up, moe_w_down):
    b, s, d = x.shape
    n_ctx = ctx.shape[1]
    x_lat, x_ctx = x, ctx
    for l in range(DEPTH):
        need_ctx = l < DEPTH - 1
        mod_lat = jax.nn.silu(c) @ ada_w[l] + ada_b[l]
        mod_ctx = jax.nn.silu(c_ctx) @ ada_w[l] + ada_b[l]
        sh1, sc1, g1, sh2, sc2, g2 = jnp.split(mod_lat[:, None, :], 6, axis=-1)
        ch1, cs1, cg1, ch2, cs2, cg2 = jnp.split(mod_ctx, 6)
        h_lat = rms_norm(x_lat, norm1_g[l]) * (1.0 + sc1) + sh1
        h_ctx = rms_norm(x_ctx, norm1_g[l]) * (1.0 + cs1) + ch1
        i = l // 2
        if l % 2 == 0:
            w_in, w_out = ev_w_in[i], ev_w_out[i]
            p_lat, p_ctx = h_lat @ w_in, h_ctx @ w_in
            a_lat, a_ctx = mixer_a(p_lat[..., :A_IN], p_ctx[..., :A_IN], a_q_norm[i], a_k_norm[i], need_ctx)
            b_lat = chunk_spatial_gate(p_lat[..., A_IN:], b_v_norm[i], b_ws[i], b_bs[i])
            m_lat = jnp.concatenate([a_lat, b_lat], axis=-1)
            if need_ctx:
                b_ctx = chunk_spatial_gate(p_ctx[..., A_IN:], b_v_norm[i], b_ws[i], b_bs[i])
                m_ctx = jnp.concatenate([a_ctx, b_ctx], axis=-1)
        else:
            w_in, w_out = od_w_in[i], od_w_out[i]
            p_lat, p_ctx = h_lat @ w_in, h_ctx @ w_in
            c_lat, c_ctx_o = mixer_c(p_lat[..., :3 * C_W], p_ctx[..., :3 * C_W], c_q_norm[i], c_k_norm[i], c_rpb[i], need_ctx)
            d_lat = conformer_conv(p_lat[..., 3 * C_W:], d_dw[i], d_dw_b[i], d_ln_g[i], d_ln_b[i])
            m_lat = jnp.concatenate([c_lat, d_lat], axis=-1)
            if need_ctx:
                d_ctx = conformer_conv(p_ctx[..., 3 * C_W:], d_dw[i], d_dw_b[i], d_ln_g[i], d_ln_b[i])
                m_ctx = jnp.concatenate([c_ctx_o, d_ctx], axis=-1)
        x_lat = x_lat + g1 * (m_lat @ w_out)
        h2_lat = rms_norm(x_lat, norm2_g[l]) * (1.0 + sc2) + sh2
        if need_ctx:
            x_ctx = x_ctx + cg1 * (m_ctx @ w_out)
            h2_ctx = rms_norm(x_ctx, norm2_g[l]) * (1.0 + cs2) + ch2
            toks = jnp.concatenate([h2_lat.reshape(b * s, d), h2_ctx.reshape(b * n_ctx, d)], axis=0)
            f = moe_ffn(toks, router_w, router_b, moe_w_gate[l], moe_w_up[l], moe_w_down[l])
            f_lat = f[:b * s].reshape(b, s, d)
            x_ctx = x_ctx + cg2 * f[b * s:].reshape(b, n_ctx, d)
        else:
            f_lat = moe_ffn(h2_lat.reshape(b * s, d), router_w, router_b, moe_w_gate[l], moe_w_up[l], moe_w_down[l]).reshape(b, s, d)
        x_lat = x_lat + g2 * f_lat
    return x_lat
```

```cpp
#include <hip/hip_runtime.h>
#include <cstdint>
#include <cstdio>

#define DEV __device__ __forceinline__
#define LAS __attribute__((address_space(3)))
typedef unsigned short bf16_t;
typedef short bf16x8 __attribute__((ext_vector_type(8)));
typedef float f32x4 __attribute__((ext_vector_type(4)));
typedef float f32x2 __attribute__((ext_vector_type(2)));
typedef float f32x16 __attribute__((ext_vector_type(16)));
typedef unsigned u32x4 __attribute__((ext_vector_type(4)));
typedef unsigned u32x2 __attribute__((ext_vector_type(2)));

constexpr int DM = 1024, SEQ = 16384, NCTX = 256, NTOK = SEQ + NCTX, DEPTH = 4, GRIDW = 64;
constexpr int EV_IN = 1792, OD_IN = 2560, NEXP = 16, DEXP = 512;
constexpr int MAXBLK = 146;
constexpr float EPS = 1e-6f;
constexpr int NWAVES = 8, NTHR = 512;

constexpr size_t MiB = 1u << 20;
constexpr size_t WS_CTL = 0, CTL_BYTES = 1 * MiB;
constexpr size_t WS_MOD = 1 * MiB;
constexpr size_t WS_ROPE = 1 * MiB + 256 * 1024;
constexpr size_t WS_CNT = 1 * MiB + 512 * 1024;
constexpr size_t WS_BLK = 1 * MiB + 768 * 1024;
constexpr size_t WS_TOK = 2 * MiB;
constexpr size_t WS_XCTX = 3 * MiB;
constexpr size_t WS_WEVIN = 4 * MiB;
constexpr size_t WS_WEVOUT = 11 * MiB;
constexpr size_t WS_WODIN = 15 * MiB;
constexpr size_t WS_WODOUT = 25 * MiB;
constexpr size_t WS_BWS = 29 * MiB;
constexpr size_t WS_WGU = 30 * MiB;
constexpr size_t WS_WDN = 158 * MiB;
constexpr size_t WS_H = 222 * MiB;
constexpr size_t WS_P = 255 * MiB;
constexpr size_t WS_MX = 337 * MiB;
constexpr size_t WS_BUF = 370 * MiB;
constexpr size_t WS_ACT = 443 * MiB;
constexpr size_t WS_END = 480 * MiB;
static_assert(WS_H + (size_t)NTOK * DM * 2 <= WS_P && WS_P + (size_t)NTOK * OD_IN * 2 <= WS_MX && WS_P + (size_t)MAXBLK * 256 * DM * 2 <= WS_MX, "ws map");
static_assert(WS_MX + (size_t)NTOK * DM * 2 <= WS_BUF && WS_BUF + (size_t)MAXBLK * 256 * DM * 2 <= WS_ACT && WS_ACT + (size_t)MAXBLK * 256 * DEXP * 2 <= WS_END, "ws map");

constexpr int LDS_BYTES = 147456;
#ifndef N_LAUNCHES
#define N_LAUNCHES 1
#endif

struct TokInfo { int e0, e1; float w0, w1; int r0, r1, d0, d1; };
struct KArgs { const float* in[29]; float* out; unsigned char* ws; int ph_lo, ph_hi; };
enum { I_X = 0, I_C, I_CTX, I_CCTX, I_RW, I_RB, I_ADAW, I_ADAB, I_N1G, I_N2G, I_EVIN, I_EVOUT, I_AQN, I_AKN, I_BVN, I_BWS, I_BBS,
       I_ODIN, I_ODOUT, I_CQN, I_CKN, I_RPB, I_DDW, I_DDWB, I_DLNG, I_DLNB, I_MG, I_MU, I_MD };

DEV float bf2f(bf16_t v) { return __uint_as_float((unsigned)v << 16); }
DEV float bf2f_s(short v) { return __uint_as_float(((unsigned)(unsigned short)v) << 16); }
DEV unsigned f2bf(float f) { unsigned u = __float_as_uint(f); return (u + 0x7fffu + ((u >> 16) & 1u)) >> 16; }
DEV unsigned pk2(float lo, float hi) { return f2bf(lo) | (f2bf(hi) << 16); }
DEV float wave_sum(float v) {
#pragma unroll
    for (int o = 1; o < 64; o <<= 1) v += __shfl_xor(v, o);
    return v;
}
DEV float sigmoidf_(float x) { return 1.f / (1.f + __expf(-x)); }
DEV float siluf_(float x) { return x / (1.f + __expf(-x)); }
DEV float gelu_tanh(float x) { const float u = 0.7978845608028654f * (x + 0.044715f * x * x * x); const float t = 1.f - 2.f / (__expf(2.f * u) + 1.f); return 0.5f * x * (1.f + t); }
DEV void unpack8(const bf16x8 v, float* f) {
#pragma unroll
    for (int j = 0; j < 8; ++j) f[j] = bf2f_s(v[j]);
}
DEV u32x4 pack8(const float* f) { u32x4 o; o.x = pk2(f[0], f[1]); o.y = pk2(f[2], f[3]); o.z = pk2(f[4], f[5]); o.w = pk2(f[6], f[7]); return o; }

typedef const __attribute__((address_space(4))) KArgs* KArgsP;
DEV KArgsP kargs() { KArgsP p = (KArgsP)__builtin_amdgcn_kernarg_segment_ptr(); asm volatile("" : "+s"(p)); return p; }
struct Fr { int tid, lane, wave, bid, G, gw, NGW; LAS unsigned char* lds; };

DEV const float* xrow_in(KArgsP a, int l, int row) {
    if (l == 0) return row < SEQ ? a->in[I_X] + (size_t)row * DM : a->in[I_CTX] + (size_t)(row - SEQ) * DM;
    return row < SEQ ? a->out + (size_t)row * DM : (const float*)(a->ws + WS_XCTX) + (size_t)(row - SEQ) * DM;
}
DEV float* xrow_out(KArgsP a, int row) { return row < SEQ ? a->out + (size_t)row * DM : (float*)(a->ws + WS_XCTX) + (size_t)(row - SEQ) * DM; }
DEV const float* modp(KArgsP a, int l, int row, int j) { return (const float*)(a->ws + WS_MOD) + (size_t)(l * 2 + (row < SEQ ? 0 : 1)) * 6144 + j * 1024; }

DEV void transpose_item(const float* W, int K, int N, int k0, int n0, bf16_t* drow0, LAS float* scr, int lane) {
#pragma unroll 8
    for (int i = 0; i < 32; ++i) { const int kk = 2 * i + (lane >> 5); scr[kk * 33 + (lane & 31)] = W[(size_t)(k0 + kk) * N + n0 + (lane & 31)]; }
    asm volatile("s_waitcnt lgkmcnt(0)" ::: "memory");
    const int c = lane & 7;
#pragma unroll
    for (int j = 0; j < 4; ++j) { const int n = (lane >> 3) + 8 * j; const LAS float* s = scr + (8 * c) * 33 + n;
        u32x4 o; o.x = pk2(s[0 * 33], s[1 * 33]); o.y = pk2(s[2 * 33], s[3 * 33]); o.z = pk2(s[4 * 33], s[5 * 33]); o.w = pk2(s[6 * 33], s[7 * 33]);
        *(u32x4*)(drow0 + (size_t)n * K + k0 + 8 * c) = o; }
    asm volatile("s_waitcnt lgkmcnt(0)" ::: "memory");
}

DEV void phase_pro_a(KArgsP a, const Fr& F) {
    LAS float* sl = (LAS float*)F.lds;
    LAS float* red = sl + 2048;
    float* mod = (float*)(a->ws + WS_MOD);
    bool loaded = false;
    for (int it = F.bid; it < 96; it += F.G) {
        if (!loaded) {
            for (int i = F.tid; i < 2048; i += NTHR) { const float v = i < 1024 ? a->in[I_C][i] : a->in[I_CCTX][i - 1024]; sl[i] = siluf_(v); }
            __syncthreads(); loaded = true;
        }
        const int l = it / 24, cg = it % 24, n0 = cg * 256 + 4 * F.lane;
        const float* W = a->in[I_ADAW] + (size_t)l * 1024 * 6144 + n0;
        f32x4 a0 = {0.f, 0.f, 0.f, 0.f}, a1 = {0.f, 0.f, 0.f, 0.f};
        const int kb = F.wave * 128;
#pragma unroll 8
        for (int k = 0; k < 128; ++k) { const f32x4 w = *(const f32x4*)(W + (size_t)(kb + k) * 6144); a0 += w * sl[kb + k]; a1 += w * sl[1024 + kb + k]; }
#pragma unroll
        for (int j = 0; j < 4; ++j) { red[(F.wave * 2 + 0) * 256 + 4 * F.lane + j] = a0[j]; red[(F.wave * 2 + 1) * 256 + 4 * F.lane + j] = a1[j]; }
        __syncthreads();
        { const int s = F.tid >> 8, n = F.tid & 255; float sum = a->in[I_ADAB][l * 6144 + cg * 256 + n];
#pragma unroll
          for (int w = 0; w < 8; ++w) sum += red[(w * 2 + s) * 256 + n];
          mod[(size_t)(l * 2 + s) * 6144 + cg * 256 + n] = sum; }
        __syncthreads();
    }
    if (F.bid == F.G - 1) {
        f32x2* tab = (f32x2*)(a->ws + WS_ROPE);
        for (int i = F.tid; i < 256 * 16; i += NTHR) { const int pos = i >> 4, f = i & 15;
            const float inv = exp2f(-(float)f * (13.287712379549449f / 16.f)); const float ang = (float)pos * inv;
            double rev = (double)ang * 0.15915494309189535; rev -= floor(rev); const float r = (float)rev;
            tab[i] = (f32x2){__builtin_amdgcn_cosf(r), __builtin_amdgcn_sinf(r)}; }
    }
    LAS float* scr = (LAS float*)(F.lds + 32768 + F.wave * 8448);
    constexpr int T0 = 2 * 896, T1 = T0 + 2 * 512, T2 = T1 + 2 * 1280, T3 = T2 + 2 * 512, T4 = T3 + 64 * 256, T5 = T4 + 64 * 256, T6 = T5 + 64 * 256;
    for (int it = F.gw; it < T6; it += F.NGW) {
        if (it < T0) { const int i = it / 896, r = it % 896; transpose_item(a->in[I_EVIN] + (size_t)i * 1024 * EV_IN, 1024, EV_IN, 64 * (r / 56), 32 * (r % 56), (bf16_t*)(a->ws + WS_WEVIN) + (size_t)i * EV_IN * 1024 + (size_t)(32 * (r % 56)) * 1024, scr, F.lane); }
        else if (it < T1) { const int q = it - T0, i = q / 512, r = q % 512; transpose_item(a->in[I_EVOUT] + (size_t)i * 1024 * 1024, 1024, 1024, 64 * (r / 32), 32 * (r % 32), (bf16_t*)(a->ws + WS_WEVOUT) + (size_t)i * 1024 * 1024 + (size_t)(32 * (r % 32)) * 1024, scr, F.lane); }
        else if (it < T2) { const int q = it - T1, i = q / 1280, r = q % 1280; transpose_item(a->in[I_ODIN] + (size_t)i * 1024 * OD_IN, 1024, OD_IN, 64 * (r / 80), 32 * (r % 80), (bf16_t*)(a->ws + WS_WODIN) + (size_t)i * OD_IN * 1024 + (size_t)(32 * (r % 80)) * 1024, scr, F.lane); }
        else if (it < T3) { const int q = it - T2, i = q / 512, r = q % 512; transpose_item(a->in[I_ODOUT] + (size_t)i * 1024 * 1024, 1024, 1024, 64 * (r / 32), 32 * (r % 32), (bf16_t*)(a->ws + WS_WODOUT) + (size_t)i * 1024 * 1024 + (size_t)(32 * (r % 32)) * 1024, scr, F.lane); }
        else if (it < T5) { const bool up = it >= T4; const int q = it - (up ? T4 : T3), m = q / 256, r = q % 256, n0 = 32 * (r % 16);
            const int drow = 256 * (n0 / 128) + (up ? 128 : 0) + (n0 % 128);
            transpose_item(a->in[up ? I_MU : I_MG] + (size_t)m * 1024 * 512, 1024, 512, 64 * (r / 16), n0, (bf16_t*)(a->ws + WS_WGU) + (size_t)m * 1024 * 1024 + (size_t)drow * 1024, scr, F.lane); }
        else { const int q = it - T5, m = q / 256, r = q % 256, n0 = 32 * (r % 32);
            transpose_item(a->in[I_MD] + (size_t)m * 512 * 1024, 512, 1024, 64 * (r / 32), n0, (bf16_t*)(a->ws + WS_WDN) + (size_t)m * 1024 * 512 + (size_t)n0 * 512, scr, F.lane); }
    }
}

DEV void modnorm_regs(const f32x4 (&v)[4], const float* g, const float* sc, const float* sh, bf16_t* orow, int lane) {
    float s = 0.f;
#pragma unroll
    for (int j = 0; j < 4; ++j) s += (v[j].x * v[j].x + v[j].y * v[j].y) + (v[j].z * v[j].z + v[j].w * v[j].w);
    const float rstd = rsqrtf(wave_sum(s) * (1.f / DM) + EPS);
#pragma unroll
    for (int j = 0; j < 4; ++j) { const int c4 = 64 * j + lane; const f32x4 G = ((const f32x4*)g)[c4], SC = ((const f32x4*)sc)[c4], SH = ((const f32x4*)sh)[c4];
        const f32x4 o = v[j] * rstd * G * (SC + 1.f) + SH; u32x2 w; w.x = pk2(o.x, o.y); w.y = pk2(o.z, o.w); ((u32x2*)orow)[c4] = w; }
}

DEV void phase_pro_b(KArgsP a, const Fr& F) {
    bf16_t* H = (bf16_t*)(a->ws + WS_H);
    for (int row = F.gw; row < NTOK; row += F.NGW) {
        const float* xr = xrow_in(a, 0, row); f32x4 v[4];
#pragma unroll
        for (int j = 0; j < 4; ++j) v[j] = ((const f32x4*)xr)[64 * j + F.lane];
        modnorm_regs(v, a->in[I_N1G], modp(a, 0, row, 1), modp(a, 0, row, 0), H + (size_t)row * DM, F.lane);
    }
}

template <class Epi> DEV void gemm_simple(const bf16_t* A, const bf16_t* Bt, int M, int N, int K, const Epi& E, const Fr& F) {
    const int ntn = N / 32, total = (M / 32) * ntn, r32 = F.lane & 31, hi = F.lane >> 5;
    for (int t = F.gw; t < total; t += F.NGW) {
        const int m0 = (t / ntn) * 32, n0 = (t % ntn) * 32;
        f32x16 acc = {};
        const bf16_t* ap = A + (size_t)(m0 + r32) * K + 8 * hi; const bf16_t* bp = Bt + (size_t)(n0 + r32) * K + 8 * hi;
        for (int k = 0; k < K; k += 16) acc = __builtin_amdgcn_mfma_f32_32x32x16_bf16(*(const bf16x8*)(ap + k), *(const bf16x8*)(bp + k), acc, 0, 0, 0);
#pragma unroll
        for (int r = 0; r < 16; ++r) E(m0 + (r & 3) + 8 * (r >> 2) + 4 * hi, n0 + r32, acc[r]);
    }
}
struct EpiP { bf16_t* P; int ldc; DEV void operator()(int row, int col, float v) const { P[(size_t)row * ldc + col] = (bf16_t)f2bf(v); } };
struct EpiRes { KArgsP a; int l; DEV void operator()(int row, int col, float v) const { const float* xi = xrow_in(a, l, row); float* xo = xrow_out(a, row); xo[col] = xi[col] + modp(a, l, row, 2)[col] * v; } };

DEV void load64(const bf16_t* p, float* x) {
#pragma unroll
    for (int c = 0; c < 8; ++c) unpack8(((const bf16x8*)p)[c], x + 8 * c);
}
DEV void store64(bf16_t* p, const float* x) {
#pragma unroll
    for (int c = 0; c < 8; ++c) ((u32x4*)p)[c] = pack8(x + 8 * c);
}
DEV float sum8lanes(float v) { v += __shfl_xor(v, 1); v += __shfl_xor(v, 2); v += __shfl_xor(v, 4); return v; }
DEV void phase_pre_even(KArgsP a, const Fr& F, int i) {
    bf16_t* P = (bf16_t*)(a->ws + WS_P); const f32x2* tab = (const f32x2*)(a->ws + WS_ROPE);
    const int total = NTOK * 26 * 8;
    for (int it = F.bid * NTHR + F.tid; it < total; it += F.G * NTHR) {
        const int j8 = it & 7, gidx = it >> 3, row = gidx / 26, gi = gidx % 26, grp = gi < 10 ? gi : gi + 2;
        bf16_t* p = P + (size_t)row * EV_IN + grp * 64 + 8 * j8; float x[8]; unpack8(*(const bf16x8*)p, x);
        if (grp >= 12) {
#pragma unroll
            for (int d = 0; d < 8; ++d) x[d] = gelu_tanh(x[d]);
        }
        float ss = 0.f;
#pragma unroll
        for (int d = 0; d < 8; ++d) ss += x[d] * x[d];
        ss = sum8lanes(ss);
        const float r = rsqrtf(ss * (1.f / 64.f) + EPS);
        if (grp < 10 || grp >= 20) {
            const float* gn = grp < 8 ? a->in[I_AQN] + i * 64 : (grp < 10 ? a->in[I_AKN] + i * 64 : a->in[I_BVN] + i * 512 + (grp - 20) * 64);
#pragma unroll
            for (int d = 0; d < 8; ++d) x[d] *= r * gn[8 * j8 + d];
        }
        float y[8];
#pragma unroll
        for (int d = 0; d < 8; ++d) y[d] = __shfl_xor(x[d], 2);
        if (grp < 10 && row < SEQ) {
            const int pos = (j8 & 4) ? (row % GRIDW) : (row / GRIDW); const bool second = (j8 & 2) != 0;
#pragma unroll
            for (int d = 0; d < 8; ++d) { const f32x2 cs = tab[pos * 16 + 8 * (j8 & 1) + d]; x[d] = second ? (x[d] * cs.x + y[d] * cs.y) : (x[d] * cs.x - y[d] * cs.y); }
        }
        *(u32x4*)p = pack8(x);
    }
}
DEV void phase_pre_odd(KArgsP a, const Fr& F, int i) {
    bf16_t* P = (bf16_t*)(a->ws + WS_P);
    const int total = NTOK * 24 * 8;
    for (int it = F.bid * NTHR + F.tid; it < total; it += F.G * NTHR) {
        const int j8 = it & 7, gidx = it >> 3, row = gidx / 24, gi = gidx % 24;
        bf16_t* p = P + (size_t)row * OD_IN + (gi < 16 ? gi * 64 : 1536 + (gi - 16) * 64) + 8 * j8; float x[8]; unpack8(*(const bf16x8*)p, x);
        float ss = 0.f;
#pragma unroll
        for (int d = 0; d < 8; ++d) ss += x[d] * x[d];
        ss = sum8lanes(ss);
        if (gi < 16) {
            const float r = rsqrtf(ss * (1.f / 64.f) + EPS); const float* gn = a->in[gi < 8 ? I_CQN : I_CKN] + i * 64;
#pragma unroll
            for (int d = 0; d < 8; ++d) x[d] *= r * gn[8 * j8 + d];
        } else {
            float xg[8]; unpack8(*(const bf16x8*)(p + 512), xg);
#pragma unroll
            for (int d = 0; d < 8; ++d) x[d] *= sigmoidf_(xg[d]);
        }
        *(u32x4*)p = pack8(x);
    }
}

struct OnlineSm { float q[64], o[64], m, l; };
DEV void osm_init(OnlineSm& S, const bf16_t* qp, float scale) {
    load64(qp, S.q);
#pragma unroll
    for (int d = 0; d < 64; ++d) { S.q[d] *= scale; S.o[d] = 0.f; }
    S.m = -1e30f; S.l = 0.f;
}
DEV void osm_key(OnlineSm& S, const bf16_t* kp, const bf16_t* vp, float bias) {
    float s = bias;
#pragma unroll
    for (int c = 0; c < 8; ++c) { float kf[8]; unpack8(((const bf16x8*)kp)[c], kf);
#pragma unroll
        for (int j = 0; j < 8; ++j) s += S.q[8 * c + j] * kf[j]; }
    if (s > S.m) { const float sc = __expf(S.m - s); S.l *= sc;
#pragma unroll
        for (int d = 0; d < 64; ++d) S.o[d] *= sc;
        S.m = s; }
    const float p = __expf(s - S.m); S.l += p;
#pragma unroll
    for (int c = 0; c < 8; ++c) { float vf[8]; unpack8(((const bf16x8*)vp)[c], vf);
#pragma unroll
        for (int j = 0; j < 8; ++j) S.o[8 * c + j] += p * vf[j]; }
}
DEV void osm_store(OnlineSm& S, bf16_t* op) {
    const float rl = 1.f / S.l;
#pragma unroll
    for (int d = 0; d < 64; ++d) S.o[d] *= rl;
    store64(op, S.o);
}

DEV void phase_mix_even(KArgsP a, const Fr& F, int i) {
    const bf16_t* P = (const bf16_t*)(a->ws + WS_P); bf16_t* MX = (bf16_t*)(a->ws + WS_MX);
    for (int it = F.gw; it < (NTOK / 64) * 8; it += F.NGW) {
        const int rb = it >> 3, h = it & 7, row = rb * 64 + F.lane, kvh = h >> 2;
        OnlineSm S; osm_init(S, P + (size_t)row * EV_IN + h * 64, 0.125f);
        const int nk = row < SEQ ? NTOK : NCTX;
        for (int kk = 0; kk < nk; ++kk) { const int krow = kk < NCTX ? SEQ + kk : kk - NCTX; const bf16_t* kp = P + (size_t)krow * EV_IN + 512 + kvh * 64; osm_key(S, kp, kp + 128, 0.f); }
        osm_store(S, MX + (size_t)row * DM + h * 64);
    }
    LAS float* vn = (LAS float*)F.lds;
    LAS float* wsl = vn + 128 * 64;
    const float* BW = a->in[I_BWS] + (size_t)i * 8 * 128 * 128; const float* BB = a->in[I_BBS] + i * 8 * 128;
    for (int it = F.bid; it < (NTOK / 128) * 8; it += F.G) {
        const int n = it >> 3, g = it & 7;
        __syncthreads();
        for (int e = F.tid; e < 128 * 64; e += NTHR) { const int s = e >> 6, c = e & 63; vn[e] = bf2f(P[(size_t)(n * 128 + s) * EV_IN + 1280 + g * 64 + c]); }
        for (int e = F.tid; e < 128 * 128; e += NTHR) wsl[e] = BW[(size_t)g * 128 * 128 + e];
        __syncthreads();
        const int c = F.tid & 63, t0 = (F.tid >> 6) * 16; float acc[16];
#pragma unroll
        for (int q = 0; q < 16; ++q) acc[q] = 0.f;
        for (int s = 0; s < 128; s += 4) { const float v0 = vn[s * 64 + c], v1 = vn[(s + 1) * 64 + c], v2 = vn[(s + 2) * 64 + c], v3 = vn[(s + 3) * 64 + c];
#pragma unroll
            for (int q = 0; q < 16; ++q) { const f32x4 w = *(const LAS f32x4*)(wsl + (t0 + q) * 128 + s); acc[q] += (w.x * v0 + w.y * v1) + (w.z * v2 + w.w * v3); } }
#pragma unroll
        for (int q = 0; q < 16; ++q) { const int row = n * 128 + t0 + q; const float u = bf2f(P[(size_t)row * EV_IN + 768 + g * 64 + c]);
            MX[(size_t)row * DM + 512 + g * 64 + c] = (bf16_t)f2bf(u * (acc[q] + BB[g * 128 + t0 + q])); }
    }
}

DEV void phase_mix_odd(KArgsP a, const Fr& F, int i) {
    const bf16_t* P = (const bf16_t*)(a->ws + WS_P); bf16_t* MX = (bf16_t*)(a->ws + WS_MX);
    const float* rpb = a->in[I_RPB] + (size_t)i * 8 * 15 * 31;
    for (int it = F.gw; it < (NTOK / 64) * 8; it += F.NGW) {
        const int rb = it >> 3, h = it & 7, row = rb * 64 + F.lane;
        OnlineSm S; osm_init(S, P + (size_t)row * OD_IN + h * 64, 0.125f);
        if (row < SEQ) {
            const int r = rb, c = F.lane; int rs = r - 4; rs = rs < 0 ? 0 : (rs > 248 ? 248 : rs); int cs = c - 8; cs = cs < 0 ? 0 : (cs > 48 ? 48 : cs);
            for (int ii = 0; ii < 8; ++ii) for (int jj = 0; jj < 16; ++jj) { const int kr = rs + ii, kc = cs + jj;
                const bf16_t* kp = P + (size_t)(kr * GRIDW + kc) * OD_IN + 512 + h * 64; osm_key(S, kp, kp + 512, rpb[(h * 15 + (kr - r + 7)) * 31 + (kc - c + 15)]); }
        }
        for (int kk = 0; kk < NCTX; ++kk) { const bf16_t* kp = P + (size_t)(SEQ + kk) * OD_IN + 512 + h * 64; osm_key(S, kp, kp + 512, 0.f); }
        osm_store(S, MX + (size_t)row * DM + h * 64);
    }
    const float* DW = a->in[I_DDW] + (size_t)i * 31 * 512; const float* DB = a->in[I_DDWB] + i * 512;
    const float* LG = a->in[I_DLNG] + i * 512; const float* LB = a->in[I_DLNB] + i * 512;
    for (int row = F.gw; row < NTOK; row += F.NGW) {
        const int lo = row < SEQ ? 0 : SEQ, hi = row < SEQ ? SEQ : NTOK, ch = 8 * F.lane;
        float acc[8];
#pragma unroll
        for (int j = 0; j < 8; ++j) acc[j] = DB[ch + j];
        for (int w = 0; w < 31; ++w) { const int tt = row + w - 15; if (tt < lo || tt >= hi) continue;
            float y[8]; unpack8(*(const bf16x8*)(P + (size_t)tt * OD_IN + 1536 + ch), y);
            const f32x4 w0 = *(const f32x4*)(DW + w * 512 + ch), w1 = *(const f32x4*)(DW + w * 512 + ch + 4);
            acc[0] += y[0] * w0.x; acc[1] += y[1] * w0.y; acc[2] += y[2] * w0.z; acc[3] += y[3] * w0.w; acc[4] += y[4] * w1.x; acc[5] += y[5] * w1.y; acc[6] += y[6] * w1.z; acc[7] += y[7] * w1.w; }
        float s = 0.f;
#pragma unroll
        for (int j = 0; j < 8; ++j) s += acc[j];
        const float mean = wave_sum(s) * (1.f / 512.f); float q = 0.f;
#pragma unroll
        for (int j = 0; j < 8; ++j) { acc[j] -= mean; q += acc[j] * acc[j]; }
        const float rstd = rsqrtf(wave_sum(q) * (1.f / 512.f) + EPS);
#pragma unroll
        for (int j = 0; j < 8; ++j) acc[j] = siluf_(acc[j] * rstd * LG[ch + j] + LB[ch + j]);
        *(u32x4*)(MX + (size_t)row * DM + 512 + ch) = pack8(acc);
    }
}

DEV void phase_norm2(KArgsP a, const Fr& F, int l) {
    const int ntok = l < DEPTH - 1 ? NTOK : SEQ, rpw = (ntok + F.G - 1) / F.G;
    LAS float* rwt = (LAS float*)F.lds;
    LAS int* le = (LAS int*)(F.lds + 65536);
    for (int e = F.tid; e < 16384; e += NTHR) rwt[(e & 15) * 1024 + (e >> 4)] = a->in[I_RW][e];
    __syncthreads();
    bf16_t* H = (bf16_t*)(a->ws + WS_H); TokInfo* TI = (TokInfo*)(a->ws + WS_TOK);
    const int r0 = F.bid * rpw, r1 = (r0 + rpw < ntok) ? r0 + rpw : ntok;
    for (int row = r0 + F.wave; row < r1; row += NWAVES) {
        const float* xr = xrow_out(a, row); f32x4 v[4]; float s = 0.f;
#pragma unroll
        for (int j = 0; j < 4; ++j) { v[j] = ((const f32x4*)xr)[64 * j + F.lane]; s += (v[j].x * v[j].x + v[j].y * v[j].y) + (v[j].z * v[j].z + v[j].w * v[j].w); }
        const float rstd = rsqrtf(wave_sum(s) * (1.f / DM) + EPS);
        const float* g = a->in[I_N2G] + l * DM; const float* sc = modp(a, l, row, 4); const float* sh = modp(a, l, row, 3);
        float lg[16];
#pragma unroll
        for (int e = 0; e < 16; ++e) lg[e] = 0.f;
#pragma unroll
        for (int j = 0; j < 4; ++j) { const int c4 = 64 * j + F.lane; const f32x4 G = ((const f32x4*)g)[c4], SC = ((const f32x4*)sc)[c4], SH = ((const f32x4*)sh)[c4];
            const f32x4 o = v[j] * rstd * G * (SC + 1.f) + SH; u32x2 w; w.x = pk2(o.x, o.y); w.y = pk2(o.z, o.w); ((u32x2*)(H + (size_t)row * DM))[c4] = w;
#pragma unroll
            for (int e = 0; e < 16; ++e) { const f32x4 rw = *(const LAS f32x4*)(rwt + e * 1024 + 4 * c4); lg[e] += (o.x * rw.x + o.y * rw.y) + (o.z * rw.z + o.w * rw.w); } }
        float aff[16], sel[16];
#pragma unroll
        for (int e = 0; e < 16; ++e) { aff[e] = sigmoidf_(wave_sum(lg[e])); sel[e] = aff[e] + a->in[I_RB][e]; }
        int bg = 0; float bgs = -1e30f;
#pragma unroll
        for (int gq = 0; gq < 4; ++gq) { float m1 = -1e30f, m2 = -1e30f;
#pragma unroll
            for (int k = 0; k < 4; ++k) { const float x = sel[gq * 4 + k]; if (x > m1) { m2 = m1; m1 = x; } else if (x > m2) m2 = x; }
            const float gs = m1 + m2; if (gs > bgs) { bgs = gs; bg = gq; } }
        int e0 = 0, e1 = 0; float s0 = -1e30f, s1 = -1e30f, a0 = 0.f, a1 = 0.f;
#pragma unroll
        for (int e = 0; e < 16; ++e) { if ((e >> 2) == bg) { const float x = sel[e]; if (x > s0) { s1 = s0; e1 = e0; a1 = a0; s0 = x; e0 = e; a0 = aff[e]; } else if (x > s1) { s1 = x; e1 = e; a1 = aff[e]; } } }
        if (F.lane == 0) { const float inv = 1.f / (a0 + a1); TI[row].e0 = e0; TI[row].e1 = e1; TI[row].w0 = a0 * inv; TI[row].w1 = a1 * inv; le[row - r0] = e0; le[rpw + row - r0] = e1; }
    }
    __syncthreads();
    if (F.tid < 16) { const int e = F.tid; int cnt = 0;
        for (int j = 0; j < r1 - r0; ++j) { if (le[j] == e) TI[r0 + j].r0 = cnt++; else if (le[rpw + j] == e) TI[r0 + j].r1 = cnt++; }
        ((int*)(a->ws + WS_CNT))[F.bid * 16 + e] = cnt; }
}

DEV void phase_gather(KArgsP a, const Fr& F, int l) {
    const int ntok = l < DEPTH - 1 ? NTOK : SEQ, rpw = (ntok + F.G - 1) / F.G;
    LAS int* sb = (LAS int*)F.lds;
    const int* cnt = (const int*)(a->ws + WS_CNT);
    if (F.tid < 16) { int base = 0, tot = 0; for (int w = 0; w < F.G; ++w) { const int c = cnt[w * 16 + F.tid]; if (w < F.bid) base += c; tot += c; } sb[F.tid] = base; sb[16 + F.tid] = tot; }
    __syncthreads();
    if (F.tid == 0) { int ps = 0; int* blk = (int*)(a->ws + WS_BLK);
        for (int e = 0; e < 16; ++e) { sb[32 + e] = ps; const int pc = (sb[16 + e] + 255) & ~255;
            if (F.bid == 0) for (int b = ps / 256; b < (ps + pc) / 256; ++b) blk[1 + b] = e;
            ps += pc; }
        if (F.bid == 0) blk[0] = ps / 256; }
    __syncthreads();
    const bf16_t* H = (const bf16_t*)(a->ws + WS_H); bf16_t* BUF = (bf16_t*)(a->ws + WS_BUF); TokInfo* TI = (TokInfo*)(a->ws + WS_TOK);
    const int r0 = F.bid * rpw, r1 = (r0 + rpw < ntok) ? r0 + rpw : ntok;
    for (int row = r0 + F.wave; row < r1; row += NWAVES) {
        const TokInfo ti = TI[row];
        const int d0 = sb[32 + ti.e0] + sb[ti.e0] + ti.r0, d1 = sb[32 + ti.e1] + sb[ti.e1] + ti.r1;
        if (F.lane == 0) { TI[row].d0 = d0; TI[row].d1 = d1; }
        const u32x4* src = (const u32x4*)(H + (size_t)row * DM); const u32x4 v0 = src[F.lane], v1 = src[64 + F.lane];
        u32x4* q0 = (u32x4*)(BUF + (size_t)d0 * DM); u32x4* q1 = (u32x4*)(BUF + (size_t)d1 * DM);
        q0[F.lane] = v0; q0[64 + F.lane] = v1; q1[F.lane] = v0; q1[64 + F.lane] = v1;
    }
}

DEV void phase_gu_simple(KArgsP a, const Fr& F, int l) {
    const int* blk = (const int*)(a->ws + WS_BLK); const int nblk = blk[0];
    const bf16_t* BUF = (const bf16_t*)(a->ws + WS_BUF); bf16_t* ACT = (bf16_t*)(a->ws + WS_ACT);
    const int r32 = F.lane & 31, hi = F.lane >> 5;
    for (int t = F.gw; t < nblk * 128; t += F.NGW) {
        const int b = t >> 7, q = t & 127, mt = q >> 4, ct = q & 15, e = blk[1 + b];
        const bf16_t* W = (const bf16_t*)(a->ws + WS_WGU) + (size_t)(l * 16 + e) * 1024 * 1024;
        const int m0 = b * 256 + mt * 32, c0 = ct * 32, ng = 256 * (c0 / 128) + (c0 % 128);
        f32x16 ag = {}, au = {};
        const bf16_t* ap = BUF + (size_t)(m0 + r32) * DM + 8 * hi; const bf16_t* gp = W + (size_t)(ng + r32) * DM + 8 * hi; const bf16_t* up = gp + (size_t)128 * DM;
        for (int k = 0; k < DM; k += 16) { const bf16x8 av = *(const bf16x8*)(ap + k);
            ag = __builtin_amdgcn_mfma_f32_32x32x16_bf16(av, *(const bf16x8*)(gp + k), ag, 0, 0, 0); au = __builtin_amdgcn_mfma_f32_32x32x16_bf16(av, *(const bf16x8*)(up + k), au, 0, 0, 0); }
#pragma unroll
        for (int r = 0; r < 16; ++r) { const int row = m0 + (r & 3) + 8 * (r >> 2) + 4 * hi; ACT[(size_t)row * DEXP + c0 + r32] = (bf16_t)f2bf(siluf_(ag[r]) * au[r]); }
    }
}
DEV void phase_down_simple(KArgsP a, const Fr& F, int l) {
    const int* blk = (const int*)(a->ws + WS_BLK); const int nblk = blk[0];
    const bf16_t* ACT = (const bf16_t*)(a->ws + WS_ACT); bf16_t* Y = (bf16_t*)(a->ws + WS_P);
    const int r32 = F.lane & 31, hi = F.lane >> 5;
    for (int t = F.gw; t < nblk * 256; t += F.NGW) {
        const int b = t >> 8, q = t & 255, mt = q >> 5, nt = q & 31, e = blk[1 + b];
        const bf16_t* W = (const bf16_t*)(a->ws + WS_WDN) + (size_t)(l * 16 + e) * 1024 * 512;
        const int m0 = b * 256 + mt * 32, n0 = nt * 32; f32x16 acc = {};
        const bf16_t* ap = ACT + (size_t)(m0 + r32) * DEXP + 8 * hi; const bf16_t* bp = W + (size_t)(n0 + r32) * DEXP + 8 * hi;
        for (int k = 0; k < DEXP; k += 16) acc = __builtin_amdgcn_mfma_f32_32x32x16_bf16(*(const bf16x8*)(ap + k), *(const bf16x8*)(bp + k), acc, 0, 0, 0);
#pragma unroll
        for (int r = 0; r < 16; ++r) { const int row = m0 + (r & 3) + 8 * (r >> 2) + 4 * hi; Y[(size_t)row * DM + n0 + r32] = (bf16_t)f2bf(acc[r]); }
    }
}

DEV void phase_comb(KArgsP a, const Fr& F, int l) {
    const int ntok = l < DEPTH - 1 ? NTOK : SEQ;
    const bf16_t* Y = (const bf16_t*)(a->ws + WS_P); const TokInfo* TI = (const TokInfo*)(a->ws + WS_TOK); bf16_t* H = (bf16_t*)(a->ws + WS_H);
    for (int row = F.gw; row < ntok; row += F.NGW) {
        const TokInfo ti = TI[row]; float* xr = xrow_out(a, row); const float* g2 = modp(a, l, row, 5);
        const u32x2* y0 = (const u32x2*)(Y + (size_t)ti.d0 * DM); const u32x2* y1 = (const u32x2*)(Y + (size_t)ti.d1 * DM);
        f32x4 v[4];
#pragma unroll
        for (int j = 0; j < 4; ++j) { const int c4 = 64 * j + F.lane; const f32x4 x = ((const f32x4*)xr)[c4], G = ((const f32x4*)g2)[c4]; const u32x2 p0 = y0[c4], p1 = y1[c4];
            f32x4 f; f.x = ti.w0 * __uint_as_float(p0.x << 16) + ti.w1 * __uint_as_float(p1.x << 16); f.y = ti.w0 * __uint_as_float(p0.x & 0xffff0000u) + ti.w1 * __uint_as_float(p1.x & 0xffff0000u);
            f.z = ti.w0 * __uint_as_float(p0.y << 16) + ti.w1 * __uint_as_float(p1.y << 16); f.w = ti.w0 * __uint_as_float(p0.y & 0xffff0000u) + ti.w1 * __uint_as_float(p1.y & 0xffff0000u);
            v[j] = x + G * f; ((f32x4*)xr)[c4] = v[j]; }
        if (l < DEPTH - 1) modnorm_regs(v, a->in[I_N1G] + (l + 1) * DM, modp(a, l + 1, row, 1), modp(a, l + 1, row, 0), H + (size_t)row * DM, F.lane);
    }
}

#define XB_TMO      128
#define XB_XCNT(j)  (256  + 64 * (j))
#define XB_XSUB(j)  (1280 + 64 * (j))
#define XB_XGEN(j)  (2304 + 64 * (j))
#define XB_TOP      3328
#define XB_TOPGEN   3392
#define XCD_BAR_WORDS 3456
#define XB_SPIN_CAP (1u << 22)
DEV unsigned xb_ld(unsigned* p)              { return __hip_atomic_load(p, __ATOMIC_RELAXED, __HIP_MEMORY_SCOPE_AGENT); }
DEV unsigned xb_add(unsigned* p, unsigned v) { return __hip_atomic_fetch_add(p, v, __ATOMIC_RELAXED, __HIP_MEMORY_SCOPE_AGENT); }
DEV unsigned xb_xcc_id() { return (unsigned)__builtin_amdgcn_s_getreg((3 << 11) | 20) & 0xFu; }
#define XB_SPIN(cond, bar) do { unsigned _sp = 0; while (cond) { __builtin_amdgcn_s_sleep(1); \
    if ((++_sp & 255u) == 0u) { if (xb_ld(&(bar)[XB_TMO])) break; if (_sp > XB_SPIN_CAP) { atomicAdd(&(bar)[XB_TMO], 1u); break; } } } } while (0)
struct XcdBarrier { unsigned* bar; unsigned x; volatile LAS unsigned* st; };
DEV XcdBarrier xcd_barrier_post(unsigned* bar, volatile LAS unsigned* st) {
    XcdBarrier b; b.bar = bar; b.x = xb_xcc_id(); b.st = st;
    if (threadIdx.x == 0) (void)xb_add(&bar[XB_XCNT(b.x)], 1u);
    return b;
}
DEV void xcd_barrier_complete(unsigned* bar, unsigned x, unsigned& nloc, unsigned& nx) {
    const unsigned G = gridDim.x * gridDim.y * gridDim.z;
    unsigned sum, cnt, mine, sp = 0u;
    for (;;) {
        sum = 0u; cnt = 0u; mine = 0u;
#pragma unroll
        for (unsigned j = 0; j < 16; ++j) { const unsigned c = xb_ld(&bar[XB_XCNT(j)]); sum += c; cnt += (c > 0u) ? 1u : 0u; mine = (j == x) ? c : mine; }
        if (sum == G) break;
        __builtin_amdgcn_s_sleep(1);
        if ((++sp & 255u) == 0u) { if (xb_ld(&bar[XB_TMO])) break; if (sp > XB_SPIN_CAP) { atomicAdd(&bar[XB_TMO], 1u); break; } }
    }
    nloc = mine > 0u ? mine : 1u; nx = cnt > 0u ? cnt : 1u;
}
DEV void xcd_barrier(const XcdBarrier& b) {
    asm volatile("s_waitcnt vmcnt(0)" ::: "memory");
    __syncthreads();
    if (threadIdx.x == 0) {
        unsigned* bar = b.bar;
        __builtin_amdgcn_s_waitcnt(0);
        unsigned nloc = b.st[0], nx = b.st[1];
        if (nloc == 0u) { xcd_barrier_complete(bar, b.x, nloc, nx); b.st[0] = nloc; b.st[1] = nx; }
        const unsigned old = xb_add(&bar[XB_XSUB(b.x)], 1u);
        const unsigned gen = old / nloc;
        if (old + 1u == (gen + 1u) * nloc) {
            __builtin_amdgcn_fence(__ATOMIC_RELEASE, "agent");
            asm volatile("s_waitcnt vmcnt(0)" ::: "memory");
            const unsigned og = xb_add(&bar[XB_TOP], 1u);
            const unsigned tg = og / nx;
            if (og + 1u == (tg + 1u) * nx) xb_add(&bar[XB_TOPGEN], 1u);
            else XB_SPIN(xb_ld(&bar[XB_TOPGEN]) == tg, bar);
            __builtin_amdgcn_fence(__ATOMIC_ACQUIRE, "agent");
            xb_add(&bar[XB_XGEN(b.x)], 1u);
            asm volatile("s_waitcnt vmcnt(0)" ::: "memory");
        } else {
            XB_SPIN(xb_ld(&bar[XB_XGEN(b.x)]) == gen, bar);
            __builtin_amdgcn_fence(__ATOMIC_ACQUIRE, "agent");
            asm volatile("s_waitcnt vmcnt(0)" ::: "memory");
        }
    }
    __syncthreads();
}

constexpr int NPH = 2 + 9 * DEPTH;
__global__ void __launch_bounds__(NTHR, 2) mega(KArgs a_unused) {
    extern __shared__ __attribute__((aligned(16))) unsigned char lds_raw[];
    Fr F; F.tid = threadIdx.x; F.lane = F.tid & 63; F.wave = __builtin_amdgcn_readfirstlane(F.tid >> 6); F.bid = blockIdx.x; F.G = gridDim.x;
    F.gw = F.bid * NWAVES + F.wave; F.NGW = F.G * NWAVES; F.lds = (LAS unsigned char*)lds_raw;
#define IN(k) (lo <= (k) && (k) < hi)
    int lo, hi; XcdBarrier bar;
    { KArgsP a = kargs(); lo = a->ph_lo; hi = a->ph_hi;
      volatile LAS unsigned* st = (volatile LAS unsigned*)(F.lds + LDS_BYTES - 64);
      if (F.tid < 16) st[F.tid] = 0u;
      __syncthreads();
      bar = xcd_barrier_post((unsigned*)(a->ws + WS_CTL) + 4096, st); }
#define SEAM(k) do { if ((k) + 1 < hi) xcd_barrier(bar); } while (0)
    if (IN(0)) { phase_pro_a(kargs(), F); SEAM(0); }
    if (IN(1)) { phase_pro_b(kargs(), F); SEAM(1); }
    for (int l = 0; l < DEPTH; ++l) {
        const int pb = 2 + 9 * l, i = l >> 1; const bool even = (l & 1) == 0;
        if (IN(pb + 0)) { KArgsP a = kargs();
            if (even) gemm_simple((const bf16_t*)(a->ws + WS_H), (const bf16_t*)(a->ws + WS_WEVIN) + (size_t)i * EV_IN * DM, NTOK, EV_IN, DM, EpiP{(bf16_t*)(a->ws + WS_P), EV_IN}, F);
            else gemm_simple((const bf16_t*)(a->ws + WS_H), (const bf16_t*)(a->ws + WS_WODIN) + (size_t)i * OD_IN * DM, NTOK, OD_IN, DM, EpiP{(bf16_t*)(a->ws + WS_P), OD_IN}, F);
            SEAM(pb + 0); }
        if (IN(pb + 1)) { if (even) phase_pre_even(kargs(), F, i); else phase_pre_odd(kargs(), F, i); SEAM(pb + 1); }
        if (IN(pb + 2)) { if (even) phase_mix_even(kargs(), F, i); else phase_mix_odd(kargs(), F, i); SEAM(pb + 2); }
        if (IN(pb + 3)) { KArgsP a = kargs(); gemm_simple((const bf16_t*)(a->ws + WS_MX), (const bf16_t*)(a->ws + (even ? WS_WEVOUT : WS_WODOUT)) + (size_t)i * DM * DM, NTOK, DM, DM, EpiRes{a, l}, F); SEAM(pb + 3); }
        if (IN(pb + 4)) { phase_norm2(kargs(), F, l); SEAM(pb + 4); }
        if (IN(pb + 5)) { phase_gather(kargs(), F, l); SEAM(pb + 5); }
        if (IN(pb + 6)) { phase_gu_simple(kargs(), F, l); SEAM(pb + 6); }
        if (IN(pb + 7)) { phase_down_simple(kargs(), F, l); SEAM(pb + 7); }
        if (IN(pb + 8)) { phase_comb(kargs(), F, l); SEAM(pb + 8); }
    }
#undef IN
#ifdef DBG_STOP
    { KArgsP a = kargs(); xcd_barrier(bar); const bf16_t* src = (const bf16_t*)(a->ws + DBG_SRC); float* o = a->out;
      for (size_t i = (size_t)F.bid * NTHR + F.tid; i < (size_t)SEQ * DM; i += (size_t)F.G * NTHR) o[i] = bf2f(src[i]); }
#endif
}

extern "C" void kernel_launch(void* const* d_in, const int* in_sizes, int n_in, void* d_out, int out_size, void* d_ws, size_t ws_size, hipStream_t stream) {
    static int grid = 0;
    if (grid == 0) {
        if (n_in != 29 || out_size != SEQ * DM || ws_size < WS_END) { fprintf(stderr, "kernel_launch: unexpected problem (n_in %d, out %d, ws %zu)\n", n_in, out_size, ws_size); grid = -1; return; }
        int dev = 0, cus = 0, per_cu = 0;
        if (hipGetDevice(&dev) != hipSuccess || hipDeviceGetAttribute(&cus, hipDeviceAttributeMultiprocessorCount, dev) != hipSuccess) { grid = -1; return; }
        if (hipFuncSetAttribute((const void*)mega, hipFuncAttributeMaxDynamicSharedMemorySize, LDS_BYTES) != hipSuccess) { fprintf(stderr, "kernel_launch: hipFuncSetAttribute failed\n"); grid = -1; return; }
        if (hipOccupancyMaxActiveBlocksPerMultiprocessor(&per_cu, (const void*)mega, NTHR, LDS_BYTES) != hipSuccess || per_cu < 1) { fprintf(stderr, "kernel_launch: occupancy query says %d\n", per_cu); (void)hipGetLastError(); }
        grid = cus;
    }
    if (grid < 0) return;
    KArgs a{};
    for (int i = 0; i < 29; ++i) a.in[i] = (const float*)d_in[i];
    a.out = (float*)d_out; a.ws = (unsigned char*)d_ws;
    (void)hipMemsetAsync((char*)d_ws + WS_CTL, 0, CTL_BYTES, stream);
#if N_LAUNCHES == 1
    a.ph_lo = 0; a.ph_hi = NPH; hipLaunchKernelGGL(mega, dim3(grid), dim3(NTHR), LDS_BYTES, stream, a);
#else
    for (int ph = 0; ph < NPH; ++ph) { a.ph_lo = ph; a.ph_hi = ph + 1; hipLaunchKernelGGL(mega, dim3(grid), dim3(NTHR), LDS_BYTES, stream, a); }
#endif
}
```

```cpp
#include <hip/hip_runtime.h>
#include <hip/hip_bf16.h>
#include <cmath>
#include <cstdint>
#include <cstdio>

#define DEV __device__ __forceinline__
#define LAS __attribute__((address_space(3)))
typedef unsigned short bf16_t;
typedef short bf16x8 __attribute__((ext_vector_type(8)));
typedef float f32x4 __attribute__((ext_vector_type(4)));
typedef float f32x2 __attribute__((ext_vector_type(2)));
typedef float f32x16 __attribute__((ext_vector_type(16)));
typedef unsigned u32x4 __attribute__((ext_vector_type(4)));
typedef unsigned u32x2 __attribute__((ext_vector_type(2)));

constexpr int DM = 1024, SEQ = 16384, NCTX = 256, NTOK = SEQ + NCTX, DEPTH = 4, GRIDW = 64;
constexpr int EV_IN = 1792, OD_IN = 2560, NEXP = 16, DEXP = 512;
constexpr int MAXBLK = 146;
constexpr float EPS = 1e-6f;
constexpr float ATT_C2 = 0.125f * 1.4426950408889634f;
constexpr int NWAVES = 8, NTHR = 512;

constexpr size_t MiB = 1u << 20;
constexpr size_t WS_CTL = 0, CTL_BYTES = 1 * MiB;
constexpr size_t WS_MOD = 1 * MiB;
constexpr size_t WS_ROPE = 1 * MiB + 256 * 1024;
constexpr size_t WS_CNT = 1 * MiB + 512 * 1024;
constexpr size_t WS_BLK = 1 * MiB + 768 * 1024;
constexpr size_t WS_TOK = 2 * MiB;
constexpr size_t WS_XCTX = 3 * MiB;
constexpr size_t WS_WEVIN = 4 * MiB;
constexpr size_t WS_WEVOUT = 11 * MiB;
constexpr size_t WS_WODIN = 15 * MiB;
constexpr size_t WS_WODOUT = 25 * MiB;
constexpr size_t WS_BWS = 29 * MiB;
constexpr size_t WS_WGU = 30 * MiB;
constexpr size_t WS_WDN = 158 * MiB;
constexpr size_t WS_H = 222 * MiB;
constexpr size_t WS_P = 255 * MiB;
constexpr size_t WS_MX = 337 * MiB;
constexpr size_t WS_BUF = 370 * MiB;
constexpr size_t WS_ACT = 443 * MiB;
constexpr size_t WS_END = 480 * MiB;
static_assert(WS_H + (size_t)NTOK * DM * 2 <= WS_P && WS_P + (size_t)NTOK * OD_IN * 2 <= WS_MX && WS_P + (size_t)MAXBLK * 256 * DM * 2 <= WS_MX, "ws map");
static_assert(WS_MX + (size_t)NTOK * DM * 2 <= WS_BUF && WS_BUF + (size_t)MAXBLK * 256 * DM * 2 <= WS_ACT && WS_ACT + (size_t)MAXBLK * 256 * DEXP * 2 <= WS_END, "ws map");

constexpr int LDS_BYTES = 147456;
#ifndef N_LAUNCHES
#define N_LAUNCHES 1
#endif

struct TokInfo { int e0, e1; float w0, w1; int r0, r1, d0, d1; };
struct KArgs { const float* in[29]; float* out; unsigned char* ws; int ph_lo, ph_hi; };
enum { I_X = 0, I_C, I_CTX, I_CCTX, I_RW, I_RB, I_ADAW, I_ADAB, I_N1G, I_N2G, I_EVIN, I_EVOUT, I_AQN, I_AKN, I_BVN, I_BWS, I_BBS,
       I_ODIN, I_ODOUT, I_CQN, I_CKN, I_RPB, I_DDW, I_DDWB, I_DLNG, I_DLNB, I_MG, I_MU, I_MD };

DEV float bf2f(bf16_t v) { return __uint_as_float((unsigned)v << 16); }
DEV float bf2f_s(short v) { return __uint_as_float(((unsigned)(unsigned short)v) << 16); }
DEV unsigned f2bf(float f) { unsigned u = __float_as_uint(f); return (u + 0x7fffu + ((u >> 16) & 1u)) >> 16; }
DEV unsigned pk2(float lo, float hi) { return f2bf(lo) | (f2bf(hi) << 16); }
DEV float wave_sum(float v) {
#pragma unroll
    for (int o = 1; o < 64; o <<= 1) v += __shfl_xor(v, o);
    return v;
}
DEV float sigmoidf_(float x) { return 1.f / (1.f + __expf(-x)); }
DEV float siluf_(float x) { return x / (1.f + __expf(-x)); }
DEV float gelu_tanh(float x) { const float u = 0.7978845608028654f * (x + 0.044715f * x * x * x); const float t = 1.f - 2.f / (__expf(2.f * u) + 1.f); return 0.5f * x * (1.f + t); }
DEV void unpack8(const bf16x8 v, float* f) {
#pragma unroll
    for (int j = 0; j < 8; ++j) f[j] = bf2f_s(v[j]);
}
DEV u32x4 pack8(const float* f) { u32x4 o; o.x = pk2(f[0], f[1]); o.y = pk2(f[2], f[3]); o.z = pk2(f[4], f[5]); o.w = pk2(f[6], f[7]); return o; }

typedef const __attribute__((address_space(4))) KArgs* KArgsP;
DEV KArgsP kargs() { KArgsP p = (KArgsP)__builtin_amdgcn_kernarg_segment_ptr(); asm volatile("" : "+s"(p)); return p; }
struct Fr { int tid, lane, wave, bid, G, gw, NGW; LAS unsigned char* lds; };

DEV const float* xrow_in(KArgsP a, int l, int row) {
    if (l == 0) return row < SEQ ? a->in[I_X] + (size_t)row * DM : a->in[I_CTX] + (size_t)(row - SEQ) * DM;
    return row < SEQ ? a->out + (size_t)row * DM : (const float*)(a->ws + WS_XCTX) + (size_t)(row - SEQ) * DM;
}
DEV float* xrow_out(KArgsP a, int row) { return row < SEQ ? a->out + (size_t)row * DM : (float*)(a->ws + WS_XCTX) + (size_t)(row - SEQ) * DM; }
DEV const float* modp(KArgsP a, int l, int row, int j) { return (const float*)(a->ws + WS_MOD) + (size_t)(l * 2 + (row < SEQ ? 0 : 1)) * 6144 + j * 1024; }

DEV void transpose_item(const float* W, int K, int N, int k0, int n0, bf16_t* drow0, LAS float* scr, int lane) {
#pragma unroll 8
    for (int i = 0; i < 32; ++i) { const int kk = 2 * i + (lane >> 5); scr[kk * 33 + (lane & 31)] = W[(size_t)(k0 + kk) * N + n0 + (lane & 31)]; }
    asm volatile("s_waitcnt lgkmcnt(0)" ::: "memory");
    const int c = lane & 7;
#pragma unroll
    for (int j = 0; j < 4; ++j) { const int n = (lane >> 3) + 8 * j; const LAS float* s = scr + (8 * c) * 33 + n;
        u32x4 o; o.x = pk2(s[0 * 33], s[1 * 33]); o.y = pk2(s[2 * 33], s[3 * 33]); o.z = pk2(s[4 * 33], s[5 * 33]); o.w = pk2(s[6 * 33], s[7 * 33]);
        *(u32x4*)(drow0 + (size_t)n * K + k0 + 8 * c) = o; }
    asm volatile("s_waitcnt lgkmcnt(0)" ::: "memory");
}

DEV void phase_pro_a(KArgsP a, const Fr& F) {
    LAS float* sl = (LAS float*)F.lds;
    LAS float* red = sl + 2048;
    float* mod = (float*)(a->ws + WS_MOD);
    bool loaded = false;
    for (int it = F.bid; it < 96; it += F.G) {
        if (!loaded) {
            for (int i = F.tid; i < 2048; i += NTHR) { const float v = i < 1024 ? a->in[I_C][i] : a->in[I_CCTX][i - 1024]; sl[i] = siluf_(v); }
            __syncthreads(); loaded = true;
        }
        const int l = it / 24, cg = it % 24, n0 = cg * 256 + 4 * F.lane;
        const float* W = a->in[I_ADAW] + (size_t)l * 1024 * 6144 + n0;
        f32x4 a0 = {0.f, 0.f, 0.f, 0.f}, a1 = {0.f, 0.f, 0.f, 0.f};
        const int kb = F.wave * 128;
#pragma unroll 8
        for (int k = 0; k < 128; ++k) { const f32x4 w = *(const f32x4*)(W + (size_t)(kb + k) * 6144); a0 += w * sl[kb + k]; a1 += w * sl[1024 + kb + k]; }
#pragma unroll
        for (int j = 0; j < 4; ++j) { red[(F.wave * 2 + 0) * 256 + 4 * F.lane + j] = a0[j]; red[(F.wave * 2 + 1) * 256 + 4 * F.lane + j] = a1[j]; }
        __syncthreads();
        { const int s = F.tid >> 8, n = F.tid & 255; float sum = a->in[I_ADAB][l * 6144 + cg * 256 + n];
#pragma unroll
          for (int w = 0; w < 8; ++w) sum += red[(w * 2 + s) * 256 + n];
          mod[(size_t)(l * 2 + s) * 6144 + cg * 256 + n] = sum; }
        __syncthreads();
    }
    if (F.bid == F.G - 1) {
        f32x2* tab = (f32x2*)(a->ws + WS_ROPE);
        for (int i = F.tid; i < 256 * 16; i += NTHR) { const int pos = i >> 4, f = i & 15;
            const float inv = exp2f(-(float)f * (13.287712379549449f / 16.f)); const float ang = (float)pos * inv;
            double rev = (double)ang * 0.15915494309189535; rev -= floor(rev); const float r = (float)rev;
            tab[i] = (f32x2){__builtin_amdgcn_cosf(r), __builtin_amdgcn_sinf(r)}; }
    }
    LAS float* scr = (LAS float*)(F.lds + 32768 + F.wave * 8448);
    constexpr int T0 = 2 * 896, T1 = T0 + 2 * 512, T2 = T1 + 2 * 1280, T3 = T2 + 2 * 512, T4 = T3 + 64 * 256, T5 = T4 + 64 * 256, T6 = T5 + 64 * 256;
    for (int it = F.gw; it < T6; it += F.NGW) {
        if (it < T0) { const int i = it / 896, r = it % 896; transpose_item(a->in[I_EVIN] + (size_t)i * 1024 * EV_IN, 1024, EV_IN, 64 * (r / 56), 32 * (r % 56), (bf16_t*)(a->ws + WS_WEVIN) + (size_t)i * EV_IN * 1024 + (size_t)(32 * (r % 56)) * 1024, scr, F.lane); }
        else if (it < T1) { const int q = it - T0, i = q / 512, r = q % 512; transpose_item(a->in[I_EVOUT] + (size_t)i * 1024 * 1024, 1024, 1024, 64 * (r / 32), 32 * (r % 32), (bf16_t*)(a->ws + WS_WEVOUT) + (size_t)i * 1024 * 1024 + (size_t)(32 * (r % 32)) * 1024, scr, F.lane); }
        else if (it < T2) { const int q = it - T1, i = q / 1280, r = q % 1280; transpose_item(a->in[I_ODIN] + (size_t)i * 1024 * OD_IN, 1024, OD_IN, 64 * (r / 80), 32 * (r % 80), (bf16_t*)(a->ws + WS_WODIN) + (size_t)i * OD_IN * 1024 + (size_t)(32 * (r % 80)) * 1024, scr, F.lane); }
        else if (it < T3) { const int q = it - T2, i = q / 512, r = q % 512; transpose_item(a->in[I_ODOUT] + (size_t)i * 1024 * 1024, 1024, 1024, 64 * (r / 32), 32 * (r % 32), (bf16_t*)(a->ws + WS_WODOUT) + (size_t)i * 1024 * 1024 + (size_t)(32 * (r % 32)) * 1024, scr, F.lane); }
        else if (it < T5) { const bool up = it >= T4; const int q = it - (up ? T4 : T3), m = q / 256, r = q % 256, n0 = 32 * (r % 16);
            const int drow = 256 * (n0 / 128) + (up ? 128 : 0) + (n0 % 128);
            transpose_item(a->in[up ? I_MU : I_MG] + (size_t)m * 1024 * 512, 1024, 512, 64 * (r / 16), n0, (bf16_t*)(a->ws + WS_WGU) + (size_t)m * 1024 * 1024 + (size_t)drow * 1024, scr, F.lane); }
        else { const int q = it - T5, m = q / 256, r = q % 256, n0 = 32 * (r % 32);
            transpose_item(a->in[I_MD] + (size_t)m * 512 * 1024, 512, 1024, 64 * (r / 32), n0, (bf16_t*)(a->ws + WS_WDN) + (size_t)m * 1024 * 512 + (size_t)n0 * 512, scr, F.lane); }
    }
}

DEV void modnorm_regs(const f32x4 (&v)[4], const float* g, const float* sc, const float* sh, bf16_t* orow, int lane) {
    float s = 0.f;
#pragma unroll
    for (int j = 0; j < 4; ++j) s += (v[j].x * v[j].x + v[j].y * v[j].y) + (v[j].z * v[j].z + v[j].w * v[j].w);
    const float rstd = rsqrtf(wave_sum(s) * (1.f / DM) + EPS);
#pragma unroll
    for (int j = 0; j < 4; ++j) { const int c4 = 64 * j + lane; const f32x4 G = ((const f32x4*)g)[c4], SC = ((const f32x4*)sc)[c4], SH = ((const f32x4*)sh)[c4];
        const f32x4 o = v[j] * rstd * G * (SC + 1.f) + SH; u32x2 w; w.x = pk2(o.x, o.y); w.y = pk2(o.z, o.w); ((u32x2*)orow)[c4] = w; }
}

DEV void phase_pro_b(KArgsP a, const Fr& F) {
    bf16_t* H = (bf16_t*)(a->ws + WS_H);
    for (int row = F.gw; row < NTOK; row += F.NGW) {
        const float* xr = xrow_in(a, 0, row); f32x4 v[4];
#pragma unroll
        for (int j = 0; j < 4; ++j) v[j] = ((const f32x4*)xr)[64 * j + F.lane];
        modnorm_regs(v, a->in[I_N1G], modp(a, 0, row, 1), modp(a, 0, row, 0), H + (size_t)row * DM, F.lane);
    }
}

template <class Epi> DEV void gemm_simple(const bf16_t* A, const bf16_t* Bt, int M, int N, int K, const Epi& E, const Fr& F, int rowbase = 0) {
    const int ntn = N / 32, total = (M / 32) * ntn, r32 = F.lane & 31, hi = F.lane >> 5;
    for (int t = F.gw; t < total; t += F.NGW) {
        const int m0 = (t / ntn) * 32, n0 = (t % ntn) * 32;
        f32x16 acc = {};
        const bf16_t* ap = A + (size_t)(m0 + r32) * K + 8 * hi; const bf16_t* bp = Bt + (size_t)(n0 + r32) * K + 8 * hi;
        for (int k = 0; k < K; k += 16) acc = __builtin_amdgcn_mfma_f32_32x32x16_bf16(*(const bf16x8*)(ap + k), *(const bf16x8*)(bp + k), acc, 0, 0, 0);
#pragma unroll
        for (int r = 0; r < 16; ++r) E(rowbase + m0 + (r & 3) + 8 * (r >> 2) + 4 * hi, n0 + r32, acc[r]);
    }
}
struct EpiP { bf16_t* P; int ldc; DEV void operator()(int row, int col, float v) const { P[(size_t)row * ldc + col] = (bf16_t)f2bf(v); } };
struct EpiRes { KArgsP a; int l; DEV void operator()(int row, int col, float v) const { const float* xi = xrow_in(a, l, row); float* xo = xrow_out(a, row); xo[col] = xi[col] + modp(a, l, row, 2)[col] * v; } };

namespace pg8 {
#define PG8_LAS __attribute__((address_space(3)))
typedef unsigned short bf16_t;
typedef short bf16x8 __attribute__((ext_vector_type(8)));
typedef float f32x4 __attribute__((ext_vector_type(4)));
typedef unsigned u32x4 __attribute__((ext_vector_type(4)));
constexpr int BM = 256, BK = 64, HALF = 128, HTB = HALF * BK * 2  , STAGE_BYTES = 8 * HTB, NXCD = 8, WGM = 8;

__host__ __device__ __forceinline__ int lds_byte(int r, int c) { const int st = (r >> 4) * 2 + (c >> 5), rr = r & 15, cc = c & 31, ob = rr * 64 + cc * 2; return st * 1024 + (ob ^ (((ob >> 9) & 1) << 5)); }
__host__ __device__ __forceinline__ void stage_rc(int b, int& R, int& C) { const int st = b / 1024, sb = b % 1024, swz = sb ^ (((sb >> 9) & 1) << 5); R = (st >> 1) * 16 + swz / 64; C = (st & 1) * 32 + (swz % 64) / 2; }
__host__ __device__ __forceinline__ int perm32(int rho) { const int n = rho >> 4, i = rho & 15; return 8 * (i >> 2) + 4 * n + (i & 3); }

struct Unit { int pm, pn; long boff; };
struct Gemm { const bf16_t* A; const bf16_t* Bt; int M, N, K; };

struct StaticOrder {
    int nM, nN, nwg, G, c;
    __host__ __device__ void init(int M, int N, int G_, int c_) { nM = M / BM; nN = N / BM; nwg = nM * nN; G = G_; c = c_; }
    __host__ __device__ bool next(int i, Unit& u) const {
        const long L = (long)i * G + c; if (L >= nwg) return false;
        int wgid = (int)L; { const int q = nwg / NXCD, r = nwg % NXCD, xcd = wgid % NXCD, off = wgid / NXCD; wgid = (xcd < r ? xcd * (q + 1) : r * (q + 1) + (xcd - r) * q) + off; }
        const int nig = WGM * nN, gid = wgid / nig, fm = gid * WGM, gsz = (nM - fm) < WGM ? (nM - fm) : WGM;
        u.pm = fm + ((wgid % nig) % gsz); u.pn = (wgid % nig) / gsz; u.boff = 0; return true;
    }
    __device__ __forceinline__ void a_ready(const Unit&) const {}
    __device__ __forceinline__ void done(const Unit&) const {}
};


__device__ __forceinline__ unsigned cvt_pk_bf16(float lo, float hi) { unsigned r; asm volatile("v_cvt_pk_bf16_f32 %0, %1, %2" : "=v"(r) : "v"(lo), "v"(hi)); return r; }
struct EpiBf16 {
    static constexpr bool PERM = true, AFTER_DRAIN = false;
    bf16_t* O; int ldc;
    __device__ __forceinline__ void operator()(const f32x4 (&acc)[2][2][4][2], const Unit& u, int wr, int wc, int fr, int fq) const {
        const int row0 = u.pm * BM + wr * 64 + fr, col0 = u.pn * BM + wc * 32 + 8 * fq;
#pragma unroll
        for (int ai = 0; ai < 2; ++ai)
#pragma unroll
            for (int m = 0; m < 4; ++m) { bf16_t* rowp = O + (size_t)(row0 + ai * HALF + m * 16) * ldc + col0;
#pragma unroll
                for (int bj = 0; bj < 2; ++bj) { const f32x4 v0 = acc[ai][bj][m][0], v1 = acc[ai][bj][m][1];
                    u32x4 w; w.x = cvt_pk_bf16(v0[0], v0[1]); w.y = cvt_pk_bf16(v0[2], v0[3]); w.z = cvt_pk_bf16(v1[0], v1[1]); w.w = cvt_pk_bf16(v1[2], v1[3]);
                    *(u32x4*)(rowp + bj * HALF) = w; } }
    }
};
struct EpiGU {
    static constexpr bool PERM = true, AFTER_DRAIN = false;
    bf16_t* ACT;
    __device__ __forceinline__ void operator()(const f32x4 (&acc)[2][2][4][2], const Unit& u, int wr, int wc, int fr, int fq) const {
        const int row0 = u.pm * BM + wr * 64 + fr, col0 = u.pn * HALF + wc * 32 + 8 * fq;
#pragma unroll
        for (int ai = 0; ai < 2; ++ai)
#pragma unroll
            for (int m = 0; m < 4; ++m) { bf16_t* rowp = ACT + (size_t)(row0 + ai * HALF + m * 16) * 512 + col0; float o[8];
#pragma unroll
                for (int n = 0; n < 2; ++n)
#pragma unroll
                    for (int j = 0; j < 4; ++j) { const float gt = acc[ai][0][m][n][j], up = acc[ai][1][m][n][j]; o[4 * n + j] = gt * __builtin_amdgcn_rcpf(1.f + __expf(-gt)) * up; }
                u32x4 w; w.x = cvt_pk_bf16(o[0], o[1]); w.y = cvt_pk_bf16(o[2], o[3]); w.z = cvt_pk_bf16(o[4], o[5]); w.w = cvt_pk_bf16(o[6], o[7]);
                *(u32x4*)rowp = w; }
    }
};
struct EpiResF32 {
    static constexpr bool PERM = false, AFTER_DRAIN = false;
    const float* xi; float* xo; const float* gate;
    __device__ __forceinline__ void operator()(const f32x4 (&acc)[2][2][4][2], const Unit& u, int wr, int wc, int fr, int fq) const {
        const int row0 = u.pm * BM + wr * 64 + fr, col0 = u.pn * BM + wc * 32 + 4 * fq;
        f32x4 gv[2][2];
#pragma unroll
        for (int bj = 0; bj < 2; ++bj)
#pragma unroll
            for (int n = 0; n < 2; ++n) gv[bj][n] = *(const f32x4*)(gate + col0 + bj * HALF + n * 16);
#pragma unroll
        for (int ai = 0; ai < 2; ++ai)
#pragma unroll
            for (int m = 0; m < 4; ++m) { const size_t off = (size_t)(row0 + ai * HALF + m * 16) * 1024 + col0;
#pragma unroll
                for (int bj = 0; bj < 2; ++bj)
#pragma unroll
                    for (int n = 0; n < 2; ++n) *(f32x4*)(xo + off + bj * HALF + n * 16) = *(const f32x4*)(xi + off + bj * HALF + n * 16) + gv[bj][n] * acc[ai][bj][m][n]; }
    }
};
struct GroupedOrder {
    int nunits, G, c, nN; const int* blk; long wbytes;
    __device__ __forceinline__ bool next(int i, Unit& u) const {
        const long L = (long)i * G + c; if (L >= nunits) return false;
        const int b = (int)(L / nN); u.pm = b; u.pn = (int)(L % nN);
        const int e = __builtin_amdgcn_readfirstlane((int)__hip_atomic_load((const unsigned*)blk + 1 + b, __ATOMIC_RELAXED, __HIP_MEMORY_SCOPE_AGENT));
        u.boff = (long)e * wbytes; return true;
    }
    __device__ __forceinline__ void a_ready(const Unit&) const {}
    __device__ __forceinline__ void done(const Unit&) const {}
};

template <class Epi, class Sched, bool ALIGN_EPI = false, bool SP2 = false>
__device__ __forceinline__ void gemm_phase(PG8_LAS unsigned char* lds, const Gemm g, const Sched& S, const Epi& E, const int tid_in) {
    const int tid = tid_in, wid = __builtin_amdgcn_readfirstlane(tid >> 6), lane = tid & 63, wr = wid >> 2, wc = wid & 3, fr = lane & 15, fq = lane >> 4;
    const int K = g.K, nt = K / BK;
    unsigned voffA[2], voffB[2];
#pragma unroll
    for (int i = 0; i < 2; ++i) { int R, C; stage_rc(tid * 16 + i * 8192, R, C); const int Rb = Epi::PERM ? ((R & ~31) + perm32(R & 31)) : R;
        voffA[i] = (unsigned)(R * K + C) * 2u; voffB[i] = (unsigned)(Rb * K + C) * 2u; }
    const size_t kstep = (size_t)(BK * 2);
    const size_t hstep = (size_t)HALF * K * 2;
    const size_t tstep = 2 * hstep;
    const unsigned ldsw = (unsigned)wid * 1024u;
    const int aoff = lds_byte(wr * 64 + fr, fq * 8), boff = lds_byte(wc * 32 + fr, fq * 8);
#define PG8_SA(b, h) (((b) * 2 + (h)) * HTB)
#define PG8_SB(b, h) ((4 + (b) * 2 + (h)) * HTB)
#define PG8_STAGE(bufoff, gbase, voff) do { _Pragma("unroll") for (int _i = 0; _i < 2; ++_i) \
        __builtin_amdgcn_global_load_lds((const unsigned*)((const char*)(gbase) + (voff)[_i]), (PG8_LAS unsigned*)(lds + (bufoff) + ldsw + _i * 8192), 16, 0, 0); } while (0)
#define PG8_LDA(dst, b, h) do { _Pragma("unroll") for (int m = 0; m < 4; ++m) _Pragma("unroll") for (int k = 0; k < 2; ++k) dst[m][k] = *(const PG8_LAS bf16x8*)(lds + PG8_SA(b, h) + aoff + m * 2048 + k * 1024); } while (0)
#define PG8_LDB(dst, b, h) do { _Pragma("unroll") for (int n = 0; n < 2; ++n) _Pragma("unroll") for (int k = 0; k < 2; ++k) dst[n][k] = *(const PG8_LAS bf16x8*)(lds + PG8_SB(b, h) + boff + n * 2048 + k * 1024); } while (0)
#define PG8_MMA(ai, bj, At, Bt) do { __builtin_amdgcn_s_setprio(1); _Pragma("unroll") for (int m = 0; m < 4; ++m) _Pragma("unroll") for (int n = 0; n < 2; ++n) _Pragma("unroll") for (int k = 0; k < 2; ++k) \
        acc[ai][bj][m][n] = __builtin_amdgcn_mfma_f32_16x16x32_bf16(Bt[n][k], At[m][k], acc[ai][bj][m][n], 0, 0, 0); __builtin_amdgcn_s_setprio(0); } while (0)
#define PG8_WAIT_V(n) asm volatile("s_waitcnt vmcnt(" #n ")" ::: "memory")
#define PG8_WAIT_L(n) asm volatile("s_waitcnt lgkmcnt(" #n ")" ::: "memory")
#define PG8_BAR __builtin_amdgcn_s_barrier()
#define PG8_SCHED __builtin_amdgcn_sched_barrier(0)
    Unit cur, nxt; int ui = 0;
    if (!S.next(0, cur)) return;
    f32x4 acc[2][2][4][2];
#pragma unroll
    for (int a = 0; a < 2; ++a)
#pragma unroll
        for (int b = 0; b < 2; ++b)
#pragma unroll
            for (int m = 0; m < 4; ++m)
#pragma unroll
                for (int n = 0; n < 2; ++n) acc[a][b][m][n] = (f32x4){0.f, 0.f, 0.f, 0.f};
    bf16x8 At[4][2], B0[2][2], B1[2][2];
    const char* cA = (const char*)g.A + (size_t)cur.pm * tstep; const char* cB = (const char*)g.Bt + cur.boff + (size_t)cur.pn * tstep;
    S.a_ready(cur);
    if constexpr (SP2) {
        PG8_STAGE(PG8_SB(0, 0), cB, voffB); PG8_STAGE(PG8_SB(0, 1), cB + hstep, voffB); PG8_STAGE(PG8_SA(0, 0), cA, voffA); PG8_STAGE(PG8_SA(0, 1), cA + hstep, voffA);
        if (wr == 1) PG8_BAR;
        PG8_WAIT_V(2); PG8_BAR;
        PG8_STAGE(PG8_SB(1, 0), cB + kstep, voffB); PG8_STAGE(PG8_SA(1, 0), cA + kstep, voffA); PG8_STAGE(PG8_SB(1, 1), cB + hstep + kstep, voffB);
        PG8_WAIT_V(6); PG8_BAR;
    } else {
        PG8_STAGE(PG8_SB(0, 0), cB, voffB); PG8_STAGE(PG8_SA(0, 0), cA, voffA); PG8_STAGE(PG8_SB(0, 1), cB + hstep, voffB); PG8_STAGE(PG8_SA(0, 1), cA + hstep, voffA);
        if (wr == 1) PG8_BAR;
        PG8_WAIT_V(4); PG8_BAR;
        PG8_STAGE(PG8_SB(1, 0), cB + kstep, voffB); PG8_STAGE(PG8_SA(1, 0), cA + kstep, voffA); PG8_STAGE(PG8_SB(1, 1), cB + hstep + kstep, voffB);
        PG8_WAIT_V(6); PG8_BAR;
    }
    for (;;) {
        const bool has_next = S.next(ui + 1, nxt);
        const char* nA = has_next ? (const char*)g.A + (size_t)nxt.pm * tstep : cA; const char* nB = has_next ? (const char*)g.Bt + nxt.boff + (size_t)nxt.pn * tstep : cB;
        for (int t = 0; t < nt; t += 2) {
            const bool last = (t == nt - 2);
            const char* a1 = cA + (size_t)(t + 1) * kstep;
            const char* a2 = last ? nA : cA + (size_t)(t + 2) * kstep; const char* b2 = last ? nB : cB + (size_t)(t + 2) * kstep;
            const char* a3 = a2 + kstep; const char* b3 = b2 + kstep;
            if (last && has_next) S.a_ready(nxt);
            if constexpr (SP2) {
            PG8_LDB(B0, 0, 0); PG8_LDB(B1, 0, 1); PG8_SCHED; PG8_LDA(At, 0, 0); PG8_STAGE(PG8_SA(1, 1), a1 + hstep, voffA);
            PG8_WAIT_V(8); PG8_WAIT_L(0); PG8_BAR; PG8_MMA(0, 0, At, B0); PG8_MMA(0, 1, At, B1); PG8_BAR; PG8_SCHED;
            PG8_LDA(At, 0, 1); PG8_STAGE(PG8_SB(0, 0), b2, voffB); PG8_STAGE(PG8_SB(0, 1), b2 + hstep, voffB); PG8_STAGE(PG8_SA(0, 0), a2, voffA);
            PG8_WAIT_V(8); PG8_WAIT_L(0); PG8_BAR; PG8_MMA(1, 0, At, B0); PG8_MMA(1, 1, At, B1); PG8_BAR; PG8_SCHED;
            PG8_LDB(B0, 1, 0); PG8_LDB(B1, 1, 1); PG8_SCHED; PG8_LDA(At, 1, 0); PG8_STAGE(PG8_SA(0, 1), a2 + hstep, voffA);
            PG8_WAIT_V(8); PG8_WAIT_L(0); PG8_BAR; PG8_MMA(0, 0, At, B0); PG8_MMA(0, 1, At, B1); PG8_BAR; PG8_SCHED;
            PG8_LDA(At, 1, 1); PG8_STAGE(PG8_SB(1, 0), b3, voffB); PG8_STAGE(PG8_SB(1, 1), b3 + hstep, voffB); PG8_STAGE(PG8_SA(1, 0), a3, voffA);
            PG8_WAIT_V(8); PG8_WAIT_L(0); PG8_BAR; PG8_MMA(1, 0, At, B0); PG8_MMA(1, 1, At, B1); PG8_BAR; PG8_SCHED;
            } else {
            PG8_LDB(B0, 0, 0); PG8_SCHED; PG8_LDA(At, 0, 0); PG8_STAGE(PG8_SA(1, 1), a1 + hstep, voffA);
            PG8_WAIT_L(8); PG8_BAR; PG8_WAIT_L(0); PG8_MMA(0, 0, At, B0); PG8_BAR; PG8_SCHED;
            PG8_LDB(B1, 0, 1); PG8_STAGE(PG8_SB(0, 0), b2, voffB);
            PG8_BAR; PG8_WAIT_L(0); PG8_MMA(0, 1, At, B1); PG8_BAR;
            PG8_LDA(At, 0, 1); PG8_STAGE(PG8_SA(0, 0), a2, voffA);
            PG8_BAR; PG8_WAIT_L(0); PG8_MMA(1, 0, At, B0); PG8_BAR; PG8_SCHED;
            PG8_STAGE(PG8_SB(0, 1), b2 + hstep, voffB);
            PG8_WAIT_V(6); PG8_BAR; PG8_MMA(1, 1, At, B1); PG8_BAR;
            PG8_LDB(B0, 1, 0); PG8_SCHED; PG8_LDA(At, 1, 0); PG8_STAGE(PG8_SA(0, 1), a2 + hstep, voffA);
            PG8_WAIT_L(8); PG8_BAR; PG8_WAIT_L(0); PG8_MMA(0, 0, At, B0); PG8_BAR; PG8_SCHED;
            PG8_LDB(B1, 1, 1); PG8_STAGE(PG8_SB(1, 0), b3, voffB);
            PG8_BAR; PG8_WAIT_L(0); PG8_MMA(0, 1, At, B1); PG8_BAR;
            PG8_LDA(At, 1, 1); PG8_STAGE(PG8_SA(1, 0), a3, voffA);
            PG8_BAR; PG8_WAIT_L(0); PG8_MMA(1, 0, At, B0); PG8_BAR; PG8_SCHED;
            PG8_STAGE(PG8_SB(1, 1), b3 + hstep, voffB);
            PG8_WAIT_V(6); PG8_BAR; PG8_MMA(1, 1, At, B1); PG8_BAR;
            }
        }
        if constexpr (ALIGN_EPI) { if (wr == 0) PG8_BAR; }
        if constexpr (!Epi::AFTER_DRAIN) { E(acc, cur, wr, wc, fr, fq); S.done(cur); }
        if (!has_next) break;
#pragma unroll
        for (int a = 0; a < 2; ++a)
#pragma unroll
            for (int b = 0; b < 2; ++b)
#pragma unroll
                for (int m = 0; m < 4; ++m)
#pragma unroll
                    for (int n = 0; n < 2; ++n) acc[a][b][m][n] = (f32x4){0.f, 0.f, 0.f, 0.f};
        cur = nxt; cA = nA; cB = nB; ++ui;
        if constexpr (ALIGN_EPI) { if (wr == 1) PG8_BAR; }
    }
    PG8_WAIT_V(0);
    if constexpr (!ALIGN_EPI) { if (wr == 0) PG8_BAR; }
    PG8_BAR;
    if constexpr (Epi::AFTER_DRAIN) { E.fused(acc, cur, wr, wc, fr, fq, lds, wid, lane); S.done(cur); }
#undef PG8_SA
#undef PG8_SB
#undef PG8_STAGE
#undef PG8_LDA
#undef PG8_LDB
#undef PG8_MMA
#undef PG8_WAIT_V
#undef PG8_WAIT_L
#undef PG8_BAR
#undef PG8_SCHED
}

}

DEV void load64(const bf16_t* p, float* x) {
#pragma unroll
    for (int c = 0; c < 8; ++c) unpack8(((const bf16x8*)p)[c], x + 8 * c);
}
DEV void store64(bf16_t* p, const float* x) {
#pragma unroll
    for (int c = 0; c < 8; ++c) ((u32x4*)p)[c] = pack8(x + 8 * c);
}
DEV float sum8lanes(float v) { v += __shfl_xor(v, 1); v += __shfl_xor(v, 2); v += __shfl_xor(v, 4); return v; }
DEV void phase_pre_even(KArgsP a, const Fr& F, int i) {
    bf16_t* P = (bf16_t*)(a->ws + WS_P); const f32x2* tab = (const f32x2*)(a->ws + WS_ROPE);
    const int total = NTOK * 26 * 8;
    for (int it = F.bid * NTHR + F.tid; it < total; it += F.G * NTHR) {
        const int j8 = it & 7, gidx = it >> 3, row = gidx / 26, gi = gidx % 26, grp = gi < 10 ? gi : gi + 2;
        bf16_t* p = P + (size_t)row * EV_IN + grp * 64 + 8 * j8; float x[8]; unpack8(*(const bf16x8*)p, x);
        if (grp >= 12) {
#pragma unroll
            for (int d = 0; d < 8; ++d) x[d] = gelu_tanh(x[d]);
        }
        float ss = 0.f;
#pragma unroll
        for (int d = 0; d < 8; ++d) ss += x[d] * x[d];
        ss = sum8lanes(ss);
        const float r = rsqrtf(ss * (1.f / 64.f) + EPS) * (grp < 8 ? ATT_C2 : 1.f);
        if (grp < 10 || grp >= 20) {
            const float* gn = grp < 8 ? a->in[I_AQN] + i * 64 : (grp < 10 ? a->in[I_AKN] + i * 64 : a->in[I_BVN] + i * 512 + (grp - 20) * 64);
#pragma unroll
            for (int d = 0; d < 8; ++d) x[d] *= r * gn[8 * j8 + d];
        }
        float y[8];
#pragma unroll
        for (int d = 0; d < 8; ++d) y[d] = __shfl_xor(x[d], 2);
        if (grp < 10 && row < SEQ) {
            const int pos = (j8 & 4) ? (row % GRIDW) : (row / GRIDW); const bool second = (j8 & 2) != 0;
#pragma unroll
            for (int d = 0; d < 8; ++d) { const f32x2 cs = tab[pos * 16 + 8 * (j8 & 1) + d]; x[d] = second ? (x[d] * cs.x + y[d] * cs.y) : (x[d] * cs.x - y[d] * cs.y); }
        }
        *(u32x4*)p = pack8(x);
    }
}
DEV void phase_pre_odd(KArgsP a, const Fr& F, int i) {
    bf16_t* P = (bf16_t*)(a->ws + WS_P);
    const int total = NTOK * 24 * 8;
    for (int it = F.bid * NTHR + F.tid; it < total; it += F.G * NTHR) {
        const int j8 = it & 7, gidx = it >> 3, row = gidx / 24, gi = gidx % 24;
        bf16_t* p = P + (size_t)row * OD_IN + (gi < 16 ? gi * 64 : 1536 + (gi - 16) * 64) + 8 * j8; float x[8]; unpack8(*(const bf16x8*)p, x);
        float ss = 0.f;
#pragma unroll
        for (int d = 0; d < 8; ++d) ss += x[d] * x[d];
        ss = sum8lanes(ss);
        if (gi < 16) {
            const float r = rsqrtf(ss * (1.f / 64.f) + EPS); const float* gn = a->in[gi < 8 ? I_CQN : I_CKN] + i * 64;
#pragma unroll
            for (int d = 0; d < 8; ++d) x[d] *= r * gn[8 * j8 + d];
        } else {
            float xg[8]; unpack8(*(const bf16x8*)(p + 512), xg);
#pragma unroll
            for (int d = 0; d < 8; ++d) x[d] *= sigmoidf_(xg[d]);
        }
        *(u32x4*)p = pack8(x);
    }
}

namespace attn_body {
using bf16=__hip_bfloat16;
using bf16x8=__attribute__((ext_vector_type(8)))short;
using s16x4=__attribute__((ext_vector_type(4)))short;
using f32x16=__attribute__((ext_vector_type(16)))float;
using u32x4=__attribute__((ext_vector_type(4)))unsigned;
constexpr int D=64;
constexpr int NW=8,QBLK=32,QB=QBLK*NW,KVBLK=64;
constexpr int ATTN_UNIT_ROWS=QB;
__device__ __forceinline__ int crow(int r,int hi){return (r&3)+8*(r>>2)+4*hi;}
#define SBAR() __builtin_amdgcn_sched_barrier(0)
__device__ __forceinline__ void cmask(f32x16&p0,f32x16&p1,int jb,int qrel,int hi){
  const float NEG=-INFINITY; int kb=64*jb+4*hi;
  #pragma unroll
  for(int r=0;r<16;++r){int kv=kb+(r&3)+8*(r>>2); if(kv>qrel)p0[r]=NEG; if(kv+32>qrel)p1[r]=NEG;}
}

constexpr int NSLOT=3, SLOTB=8192;
constexpr int LDS_K=0, LDS_V=NSLOT*SLOTB, LDS_WS=2*NSLOT*SLOTB, LDS_OST=LDS_WS+NW*64*4, LDS_BYTES=LDS_OST+NW*4096;
constexpr float C2=0.125f*1.4426950408889634f;
__device__ __forceinline__ void glds16(const void*gsrc,unsigned lds_dst){unsigned keep;
  asm volatile("s_mov_b32 %0, m0\n\ts_mov_b32 m0, %2\n\ts_nop 0\n\tglobal_load_lds_dwordx4 %1, off\n\ts_mov_b32 m0, %0":"=&s"(keep):"v"(gsrc),"s"(lds_dst):"memory");}
__device__ __forceinline__ float max3f(float a,float b,float c){float r;asm("v_max3_f32 %0, %1, %2, %3":"=v"(r):"v"(a),"v"(b),"v"(c));return r;}
__device__ __forceinline__ float max2f(float a,float b){float r;asm("v_max_f32_e32 %0, %1, %2":"=v"(r):"v"(a),"v"(b));return r;}
__device__ __forceinline__ float fadd_s(float a,float b){float r;asm("v_add_f32_e32 %0, %1, %2":"=v"(r):"v"(a),"v"(b));return r;}
__device__ __forceinline__ float fsub_s(float a,float b){float r;asm("v_sub_f32_e32 %0, %1, %2":"=v"(r):"v"(a),"v"(b));return r;}
typedef float f32x2_t __attribute__((ext_vector_type(2))); typedef __bf16 bf16x2_t __attribute__((ext_vector_type(2)));
__device__ __forceinline__ unsigned cvtpk_s(float lo,float hi){f32x2_t v={lo,hi};bf16x2_t b=__builtin_convertvector(v,bf16x2_t);return __builtin_bit_cast(unsigned,b);}
#define WAIT_BAR(N) asm volatile("s_waitcnt vmcnt(" #N ") lgkmcnt(0)\n\ts_barrier":::"memory")

__device__ __forceinline__ void qkt(f32x16&p0,f32x16&p1,const char*Kslot,const bf16x8*qr,const f32x16&negm,int r32,int hi){
  const char*kb=Kslot+hi*1024+r32*16;
  #pragma unroll
  for(int d0=0;d0<4;++d0){
    const bf16x8 b0=*reinterpret_cast<const bf16x8*>(kb+d0*2048);
    const bf16x8 b1=*reinterpret_cast<const bf16x8*>(kb+d0*2048+512);
    if(d0==0){p0=__builtin_amdgcn_mfma_f32_32x32x16_bf16(b0,qr[0],negm,0,0,0);p1=__builtin_amdgcn_mfma_f32_32x32x16_bf16(b1,qr[0],negm,0,0,0);}
    else{p0=__builtin_amdgcn_mfma_f32_32x32x16_bf16(b0,qr[d0],p0,0,0,0);p1=__builtin_amdgcn_mfma_f32_32x32x16_bf16(b1,qr[d0],p1,0,0,0);}}
}
typedef __attribute__((address_space(3))) const char* lds_cptr;
typedef short v4i16_t __attribute__((ext_vector_type(4)));
__device__ __forceinline__ void kload8(bf16x8*kf,lds_cptr kp){
  kf[0]=*(const __attribute__((address_space(3))) bf16x8*)(kp);      kf[1]=*(const __attribute__((address_space(3))) bf16x8*)(kp+512);
  kf[2]=*(const __attribute__((address_space(3))) bf16x8*)(kp+2048); kf[3]=*(const __attribute__((address_space(3))) bf16x8*)(kp+2560);
  kf[4]=*(const __attribute__((address_space(3))) bf16x8*)(kp+4096); kf[5]=*(const __attribute__((address_space(3))) bf16x8*)(kp+4608);
  kf[6]=*(const __attribute__((address_space(3))) bf16x8*)(kp+6144); kf[7]=*(const __attribute__((address_space(3))) bf16x8*)(kp+6656);
}
__device__ __forceinline__ void kload2(bf16x8*kf,lds_cptr kp,int j){ kf[2*j]=*(const __attribute__((address_space(3))) bf16x8*)(kp+j*2048); kf[2*j+1]=*(const __attribute__((address_space(3))) bf16x8*)(kp+j*2048+512); }
__device__ __forceinline__ s16x4 vtr(lds_cptr p){ return __builtin_bit_cast(s16x4,__builtin_amdgcn_ds_read_tr16_b64_v4i16((__attribute__((address_space(3))) v4i16_t*)p)); }
__device__ __forceinline__ float rowmax(const f32x16&p0,const f32x16&p1){
  float a=max3f(p0[0],p0[1],p1[0]),b=max3f(p0[2],p0[3],p1[1]);a=max3f(a,p1[2],p1[3]);
  #pragma unroll
  for(int r=4;r<16;r+=4){a=max3f(a,p0[r],p0[r+1]);b=max3f(b,p0[r+2],p0[r+3]);a=max3f(a,p1[r],p1[r+1]);b=max3f(b,p1[r+2],p1[r+3]);}
  const float m=max2f(a,b);
  auto rr=__builtin_amdgcn_permlane32_swap(__float_as_uint(m),__float_as_uint(m),false,false);
  return max2f(__uint_as_float(rr[0]),__uint_as_float(rr[1]));
}
__device__ __forceinline__ void pv(f32x16*o,int vb,bf16x8 pa0,bf16x8 pa1,bf16x8 pa2,bf16x8 pa3){
  #pragma unroll
  for(int d0=0;d0<2;++d0){s16x4 lo[4],hi[4];
    #pragma unroll
    for(int ks=0;ks<4;++ks){
      asm volatile("ds_read_b64_tr_b16 %0,%1 offset:%c2":"=&v"(lo[ks]):"v"(vb),"i"(d0*4096+ks*1024):"memory");
      asm volatile("ds_read_b64_tr_b16 %0,%1 offset:%c2":"=&v"(hi[ks]):"v"(vb),"i"(d0*4096+ks*1024+512):"memory");}
    asm volatile("s_waitcnt lgkmcnt(0)":::"memory");SBAR();
    #define PK(k) (bf16x8){lo[k][0],lo[k][1],lo[k][2],lo[k][3],hi[k][0],hi[k][1],hi[k][2],hi[k][3]}
    o[d0]=__builtin_amdgcn_mfma_f32_32x32x16_bf16(pa0,PK(0),o[d0],0,0,0);
    o[d0]=__builtin_amdgcn_mfma_f32_32x32x16_bf16(pa1,PK(1),o[d0],0,0,0);
    o[d0]=__builtin_amdgcn_mfma_f32_32x32x16_bf16(pa2,PK(2),o[d0],0,0,0);
    o[d0]=__builtin_amdgcn_mfma_f32_32x32x16_bf16(pa3,PK(3),o[d0],0,0,0);
    #undef PK
  }
}

#ifndef ATTN_STORE16
#define ATTN_STORE16(p,v) (*(u32x4*)(p)=(v))
#endif
template<int THRL,class TM> __device__ __forceinline__ void attn_unit(const bf16*Qu,const int qp,const bf16*Kh,const bf16*Vh,const int kvp,bf16*Ou,const int op,const int NT,const TM&tm,const int tid,char*shm){
  const int lane=tid&63,r32=lane&31,hi=lane>>5; const int wid=__builtin_amdgcn_readfirstlane(tid>>6);
  const bf16*Qw=Qu+(long)(wid*QBLK)*qp;
  const unsigned lds0=(unsigned)(uintptr_t)shm;
  float*wsf=(float*)(shm+LDS_WS)+wid*64;
  const bf16*ksrc=Kh+(long)lane*kvp+wid*8;
  const bf16*vsrc=Vh+(long)(16*(wid&3)+(lane>>2))*kvp+(wid>>2)*32+(lane&3)*8;
  const unsigned kdst=lds0+LDS_K+wid*1024, vdst=lds0+LDS_V+wid*1024;
  #define DMA_K(t,slot) glds16(ksrc+(long)tm.row(t)*kvp,(unsigned)__builtin_amdgcn_readfirstlane(kdst+(slot)))
  #define DMA_V(t,slot) glds16(vsrc+(long)tm.row(t)*kvp,(unsigned)__builtin_amdgcn_readfirstlane(vdst+(slot)))
  const int vb0=(int)(lds0+LDS_V)+((lane>>4)&1)*32+(lane&3)*8+(4*hi+((lane&15)>>2))*64;
  const char*Kbase=shm+LDS_K; bf16x8 kf[8];
  const lds_cptr shm3=(lds_cptr)shm; const lds_cptr kp0=shm3+LDS_K+hi*1024+r32*16; const lds_cptr vp0=shm3+LDS_V+((lane>>4)&1)*32+(lane&3)*8+(4*hi+((lane&15)>>2))*64;
  DMA_K(0,0);DMA_V(0,0);DMA_K(1,SLOTB);
  bf16x8 qr[4];
  #pragma unroll
  for(int d0=0;d0<4;++d0)qr[d0]=*reinterpret_cast<const bf16x8*>(&Qw[(long)r32*qp+d0*16+hi*8]);
  float mhat=0.f,l_reg=0.f;f32x16 o[2];o[0]=f32x16{};o[1]=f32x16{};f32x16 negm=f32x16{};asm volatile("":"+v"(negm));
  #define CMASK(P0,P1,t) tm.mask(P0,P1,(t),wid,r32,hi)
  bool resc=false;
  #define START(P0,P1) do{ const float rm=rowmax(P0,P1); resc=false; \
    { const float dl=rm; mhat=fadd_s(mhat,dl); \
      _Pragma("unroll") for(int r=0;r<16;++r){P0[r]=fsub_s(P0[r],dl);P1[r]=fsub_s(P1[r],dl);} \
      _Pragma("unroll") for(int r=0;r<16;++r)negm[r]=-mhat; asm volatile("":"+v"(negm)); } \
    _Pragma("unroll") for(int r=0;r<16;++r)P0[r]=__builtin_amdgcn_exp2f(P0[r]); }while(0)
  #define RESC() do{ if(resc){ asm volatile("s_waitcnt lgkmcnt(0)":::"memory"); \
      _Pragma("unroll") for(int d_=0;d_<2;++d_) _Pragma("unroll") for(int r=0;r<16;++r)o[d_][r]*=wsf[crow(r,hi)]; } }while(0)
  f32x16 pA0,pA1,pB0,pB1;
  int sl_prev=0,sl_cur=0,sl_next=SLOTB;
  #define ROT() do{sl_prev=sl_cur;sl_cur=sl_next;sl_next=(sl_next==(NSLOT-1)*SLOTB)?0:sl_next+SLOTB;}while(0)
  DMA_K(2,2*SLOTB);
  WAIT_BAR(3);
  qkt(pA0,pA1,Kbase,qr,negm,r32,hi);asm volatile("s_nop 15\n\ts_nop 7":"+v"(pA0),"+v"(pA1));CMASK(pA0,pA1,0);
  START(pA0,pA1);
  _Pragma("unroll") for(int r=0;r<16;++r)pA1[r]=__builtin_amdgcn_exp2f(pA1[r]);
  WAIT_BAR(0);
  DMA_K(3,0);DMA_V(1,SLOTB);
  ROT();
  kload8(kf,kp0+sl_cur);
  WAIT_BAR(2);
  s16x4 vlo[8],vhi[8]; u32x4 pw0,pw1,pw2,pw3;
  #define PKW(P,B) cvtpk_s(P[B],P[B+1])
  #define PAF(k) __builtin_bit_cast(bf16x8,pw##k)
  #define VFR(i) (bf16x8){vlo[i][0],vlo[i][1],vlo[i][2],vlo[i][3],vhi[i][0],vhi[i][1],vhi[i][2],vhi[i][3]}
  #define PIN(x) asm volatile("":"+v"(x))
  #define MX3(a,b,c) __builtin_fmaxf(__builtin_fmaxf((a),(b)),(c))
  #define GAPA(MF,A0,A1,A2,A3,W0,W1,PW) do{ MF; sacc+=A0; sacc+=A1; sacc+=A2; sacc+=A3; PIN(sacc); W0; W1; PIN(PW); SBAR(); }while(0)
  #define EX(v) __builtin_amdgcn_exp2f(v)
  #define GAPB(MF,X,B) do{ MF; X[B]=EX(X[B]); X[B+1]=EX(X[B+1]); X[B+2]=EX(X[B+2]); X[B+3]=EX(X[B+3]); PIN(X); SBAR(); }while(0)
  #define VRD(i) do{ vlo[i]=vtr(vp_+(((i)>>2)*4096+((i)&3)*1024)); vhi[i]=vtr(vp_+(((i)>>2)*4096+((i)&3)*1024+512)); }while(0)
  #define KRD(G,j) do{ if(G){ kload2(kf,kp0+sl_next,j); SBAR(); } }while(0)
  #define STEP(C0,C1,P0,P1,t,GK,GV,GL) do{ SBAR(); \
    const lds_cptr vp_=vp0+sl_prev; \
    VRD(0); SBAR(); float sacc=(P0[0]+P0[1]); \
    GAPA(C0=__builtin_amdgcn_mfma_f32_32x32x16_bf16(kf[0],qr[0],negm,0,0,0), P0[2],P0[3],P0[4],P0[5],     pw0[0]=PKW(P0,0), pw0[1]=PKW(P0,2), pw0); \
    VRD(4); SBAR(); GAPA(C1=__builtin_amdgcn_mfma_f32_32x32x16_bf16(kf[1],qr[0],negm,0,0,0), P0[6],P0[7],P0[8],P0[9],     pw0[2]=PKW(P0,4), pw0[3]=PKW(P0,6), pw0); \
    VRD(1); SBAR(); GAPA(C0=__builtin_amdgcn_mfma_f32_32x32x16_bf16(kf[2],qr[1],C0,0,0,0),   P0[10],P0[11],P0[12],P0[13], pw1[0]=PKW(P0,8), pw1[1]=PKW(P0,10), pw1); \
    VRD(5); SBAR(); GAPA(C1=__builtin_amdgcn_mfma_f32_32x32x16_bf16(kf[3],qr[1],C1,0,0,0),   P0[14],P0[15],P1[0],P1[1],   pw1[2]=PKW(P0,12),pw1[3]=PKW(P0,14), pw1); \
    VRD(2); SBAR(); GAPA(C0=__builtin_amdgcn_mfma_f32_32x32x16_bf16(kf[4],qr[2],C0,0,0,0),   P1[2],P1[3],P1[4],P1[5],     pw2[0]=PKW(P1,0), pw2[1]=PKW(P1,2), pw2); \
    VRD(6); SBAR(); GAPA(C1=__builtin_amdgcn_mfma_f32_32x32x16_bf16(kf[5],qr[2],C1,0,0,0),   P1[6],P1[7],P1[8],P1[9],     pw2[2]=PKW(P1,4), pw2[3]=PKW(P1,6), pw2); \
    VRD(3); SBAR(); GAPA(C0=__builtin_amdgcn_mfma_f32_32x32x16_bf16(kf[6],qr[3],C0,0,0,0),   P1[10],P1[11],P1[12],P1[13], pw3[0]=PKW(P1,8), pw3[1]=PKW(P1,10), pw3); \
    VRD(7); SBAR(); GAPA(C1=__builtin_amdgcn_mfma_f32_32x32x16_bf16(kf[7],qr[3],C1,0,0,0),   P1[14],P1[15],0.f,0.f,       pw3[2]=PKW(P1,12),pw3[3]=PKW(P1,14), pw3); \
    l_reg+=sacc; \
    if(GK){DMA_K((t)+3,sl_cur);} if(GV){DMA_V((t)+1,sl_next);} \
    CMASK(C0,C1,t); \
    { float a=MX3(C0[0],C0[1],C1[0]),b=MX3(C0[2],C0[3],C1[1]); a=MX3(a,C1[2],C1[3]); \
      _Pragma("unroll") for(int r=4;r<16;r+=4){a=MX3(a,C0[r],C0[r+1]);b=MX3(b,C0[r+2],C0[r+3]);a=MX3(a,C1[r],C1[r+1]);b=MX3(b,C1[r+2],C1[r+3]);} \
      float rm=__builtin_fmaxf(a,b); { auto rr=__builtin_amdgcn_permlane32_swap(__float_as_uint(rm),__float_as_uint(rm),false,false); rm=__builtin_fmaxf(__uint_as_float(rr[0]),__uint_as_float(rr[1])); } \
      resc=false; \
      if(__builtin_expect(__any(rm>(float)THRL),0)){ const float dl=__builtin_fmaxf(rm,0.f); mhat+=dl; \
        _Pragma("unroll") for(int r=0;r<16;++r){C0[r]-=dl;C1[r]-=dl;} \
        _Pragma("unroll") for(int r=0;r<16;++r)negm[r]=-mhat; asm volatile("":"+v"(negm)); \
        const float f=__builtin_amdgcn_exp2f(-dl); l_reg*=f; if(hi==0)wsf[r32]=f; resc=true; } } \
    SBAR(); \
    GAPB(o[0]=__builtin_amdgcn_mfma_f32_32x32x16_bf16(PAF(0),VFR(0),o[0],0,0,0), C0,0); \
    GAPB(o[1]=__builtin_amdgcn_mfma_f32_32x32x16_bf16(PAF(0),VFR(4),o[1],0,0,0), C0,4); \
    KRD(GL,0); GAPB(o[0]=__builtin_amdgcn_mfma_f32_32x32x16_bf16(PAF(1),VFR(1),o[0],0,0,0), C0,8); \
    KRD(GL,1); GAPB(o[1]=__builtin_amdgcn_mfma_f32_32x32x16_bf16(PAF(1),VFR(5),o[1],0,0,0), C0,12); \
    KRD(GL,2); GAPB(o[0]=__builtin_amdgcn_mfma_f32_32x32x16_bf16(PAF(2),VFR(2),o[0],0,0,0), C1,0); \
    KRD(GL,3); GAPB(o[1]=__builtin_amdgcn_mfma_f32_32x32x16_bf16(PAF(2),VFR(6),o[1],0,0,0), C1,4); \
    GAPB(o[0]=__builtin_amdgcn_mfma_f32_32x32x16_bf16(PAF(3),VFR(3),o[0],0,0,0), C1,8); \
    GAPB(o[1]=__builtin_amdgcn_mfma_f32_32x32x16_bf16(PAF(3),VFR(7),o[1],0,0,0), C1,12); \
    }while(0)
  int t=1;
  for(;t+5<NT;t+=2){
    STEP(pB0,pB1,pA0,pA1,t,true,true,true);     WAIT_BAR(2); RESC(); ROT();
    STEP(pA0,pA1,pB0,pB1,t+1,true,true,true);   WAIT_BAR(2); RESC(); ROT();
  }
  #define ENDW(tt) do{ if((tt)+3<NT){WAIT_BAR(2);} else if((tt)+2<NT){WAIT_BAR(1);} else {WAIT_BAR(0);} }while(0)
  for(;t+1<NT;t+=2){
    STEP(pB0,pB1,pA0,pA1,t,(t+3<NT),(t+1<NT),(t+1<NT));       ENDW(t);   RESC(); ROT();
    STEP(pA0,pA1,pB0,pB1,t+1,(t+4<NT),(t+2<NT),(t+2<NT));     ENDW(t+1); RESC(); ROT();
  }
  STEP(pB0,pB1,pA0,pA1,NT-1,false,false,false); RESC();
  { float sacc=pB0[0]+pB0[1]; _Pragma("unroll") for(int r=2;r<16;++r)sacc+=pB0[r]; _Pragma("unroll") for(int r=0;r<16;++r)sacc+=pB1[r]; l_reg+=sacc;
    pw0=(u32x4){PKW(pB0,0),PKW(pB0,2),PKW(pB0,4),PKW(pB0,6)};pw1=(u32x4){PKW(pB0,8),PKW(pB0,10),PKW(pB0,12),PKW(pB0,14)};pw2=(u32x4){PKW(pB1,0),PKW(pB1,2),PKW(pB1,4),PKW(pB1,6)};pw3=(u32x4){PKW(pB1,8),PKW(pB1,10),PKW(pB1,12),PKW(pB1,14)};
    SBAR(); pv(o,vb0+sl_cur,PAF(0),PAF(1),PAF(2),PAF(3)); }
  #undef PKW
  #undef PAF
  #undef VFR
  #undef PIN
  #undef MX3
  #undef GAPA
  #undef GAPB
  #undef EX
  #undef VRD
  #undef KRD
  #undef STEP
  #undef ENDW
  {auto rr=__builtin_amdgcn_permlane32_swap(__float_as_uint(l_reg),__float_as_uint(l_reg),false,false);l_reg=__uint_as_float(rr[0])+__uint_as_float(rr[1]);}
  if(hi==0)wsf[32+r32]=l_reg;asm volatile("s_waitcnt lgkmcnt(0)":::"memory");
  float rli[16];
  #pragma unroll
  for(int r=0;r<16;++r)rli[r]=__builtin_amdgcn_rcpf(wsf[32+crow(r,hi)]);
  bf16*Ow=Ou+(long)(wid*QBLK)*op;
  { bf16*stg=(bf16*)(shm+LDS_OST)+wid*2048;
    #pragma unroll
    for(int r=0;r<16;++r){const int orow=crow(r,hi);
      #pragma unroll
      for(int d0=0;d0<2;++d0)stg[orow*64+d0*32+r32]=__float2bfloat16(o[d0][r]*rli[r]);}
    asm volatile("s_waitcnt lgkmcnt(0)":::"memory");
    #pragma unroll
    for(int i=0;i<4;++i){const int row=i*8+(lane>>3),ch=lane&7; const u32x4 v=*(const u32x4*)(stg+row*64+ch*8); ATTN_STORE16(Ow+(long)row*op+ch*8,v);} }
  asm volatile("s_waitcnt lgkmcnt(0)\n\ts_barrier":::"memory");
  #undef DMA_K
  #undef DMA_V
  #undef CMASK
  #undef START
  #undef RESC
  #undef ROT
}
constexpr int ATTN_LDS_BYTES=LDS_BYTES;
#undef SBAR
#undef WAIT_BAR
}

struct OnlineSm { float q[64], o[64], m, l; };
DEV void osm_init(OnlineSm& S, const bf16_t* qp, float scale) {
    load64(qp, S.q);
#pragma unroll
    for (int d = 0; d < 64; ++d) { S.q[d] *= scale; S.o[d] = 0.f; }
    S.m = -1e30f; S.l = 0.f;
}
DEV void osm_key(OnlineSm& S, const bf16_t* kp, const bf16_t* vp, float bias) {
    float s = bias;
#pragma unroll
    for (int c = 0; c < 8; ++c) { float kf[8]; unpack8(((const bf16x8*)kp)[c], kf);
#pragma unroll
        for (int j = 0; j < 8; ++j) s += S.q[8 * c + j] * kf[j]; }
    if (s > S.m) { const float sc = __expf(S.m - s); S.l *= sc;
#pragma unroll
        for (int d = 0; d < 64; ++d) S.o[d] *= sc;
        S.m = s; }
    const float p = __expf(s - S.m); S.l += p;
#pragma unroll
    for (int c = 0; c < 8; ++c) { float vf[8]; unpack8(((const bf16x8*)vp)[c], vf);
#pragma unroll
        for (int j = 0; j < 8; ++j) S.o[8 * c + j] += p * vf[j]; }
}
DEV void osm_store(OnlineSm& S, bf16_t* op) {
    const float rl = 1.f / S.l;
#pragma unroll
    for (int d = 0; d < 64; ++d) S.o[d] *= rl;
    store64(op, S.o);
}

struct TMDense {
    DEV int row(int t) const { return t < 4 ? SEQ + 64 * t : 64 * (t - 4); }
    DEV void mask(attn_body::f32x16&, attn_body::f32x16&, int, int, int, int) const {}
};
DEV void phase_mix_even(KArgsP a, const Fr& F, int i) {
    const bf16_t* P = (const bf16_t*)(a->ws + WS_P); bf16_t* MX = (bf16_t*)(a->ws + WS_MX);
    { typedef attn_body::bf16 abf; const int vcu = (F.G % 8 == 0) ? (F.bid % 8) * (F.G / 8) + F.bid / 8 : F.bid;
      for (int k = 0;; ++k) {
          int u; if (F.G == 256) u = k < 2 ? 2 * vcu + k : ((k == 2 && vcu < 8) ? 512 + vcu : -1); else u = (k * F.G + vcu < 520) ? k * F.G + vcu : -1;
          if (u < 0) break;
          int h, row0, NT; if (u < 512) { h = (u >> 8) * 4 + ((u & 255) >> 6); row0 = (u & 63) * 256; NT = NTOK / 64; } else { h = u - 512; row0 = SEQ; NT = NCTX / 64; }
          const int kvh = h >> 2;
          attn_body::attn_unit<8>((const abf*)P + (size_t)row0 * EV_IN + h * 64, EV_IN, (const abf*)P + 512 + kvh * 64, (const abf*)P + 640 + kvh * 64, EV_IN,
                                  (abf*)MX + (size_t)row0 * DM + h * 64, DM, NT, TMDense{}, F.tid, (char*)F.lds);
      } }
    LAS float* vn = (LAS float*)F.lds;
    LAS float* wsl = vn + 128 * 64;
    const float* BW = a->in[I_BWS] + (size_t)i * 8 * 128 * 128; const float* BB = a->in[I_BBS] + i * 8 * 128;
    for (int it = F.bid; it < (NTOK / 128) * 8; it += F.G) {
        const int n = it >> 3, g = it & 7;
        __syncthreads();
        for (int e = F.tid; e < 128 * 64; e += NTHR) { const int s = e >> 6, c = e & 63; vn[e] = bf2f(P[(size_t)(n * 128 + s) * EV_IN + 1280 + g * 64 + c]); }
        for (int e = F.tid; e < 128 * 128; e += NTHR) wsl[e] = BW[(size_t)g * 128 * 128 + e];
        __syncthreads();
        const int c = F.tid & 63, t0 = (F.tid >> 6) * 16; float acc[16];
#pragma unroll
        for (int q = 0; q < 16; ++q) acc[q] = 0.f;
        for (int s = 0; s < 128; s += 4) { const float v0 = vn[s * 64 + c], v1 = vn[(s + 1) * 64 + c], v2 = vn[(s + 2) * 64 + c], v3 = vn[(s + 3) * 64 + c];
#pragma unroll
            for (int q = 0; q < 16; ++q) { const f32x4 w = *(const LAS f32x4*)(wsl + (t0 + q) * 128 + s); acc[q] += (w.x * v0 + w.y * v1) + (w.z * v2 + w.w * v3); } }
#pragma unroll
        for (int q = 0; q < 16; ++q) { const int row = n * 128 + t0 + q; const float u = bf2f(P[(size_t)row * EV_IN + 768 + g * 64 + c]);
            MX[(size_t)row * DM + 512 + g * 64 + c] = (bf16_t)f2bf(u * (acc[q] + BB[g * 128 + t0 + q])); }
    }
}

DEV void phase_mix_odd(KArgsP a, const Fr& F, int i) {
    const bf16_t* P = (const bf16_t*)(a->ws + WS_P); bf16_t* MX = (bf16_t*)(a->ws + WS_MX);
    const float* rpb = a->in[I_RPB] + (size_t)i * 8 * 15 * 31;
    for (int it = F.gw; it < (NTOK / 64) * 8; it += F.NGW) {
        const int rb = it >> 3, h = it & 7, row = rb * 64 + F.lane;
        OnlineSm S; osm_init(S, P + (size_t)row * OD_IN + h * 64, 0.125f);
        if (row < SEQ) {
            const int r = rb, c = F.lane; int rs = r - 4; rs = rs < 0 ? 0 : (rs > 248 ? 248 : rs); int cs = c - 8; cs = cs < 0 ? 0 : (cs > 48 ? 48 : cs);
            for (int ii = 0; ii < 8; ++ii) for (int jj = 0; jj < 16; ++jj) { const int kr = rs + ii, kc = cs + jj;
                const bf16_t* kp = P + (size_t)(kr * GRIDW + kc) * OD_IN + 512 + h * 64; osm_key(S, kp, kp + 512, rpb[(h * 15 + (kr - r + 7)) * 31 + (kc - c + 15)]); }
        }
        for (int kk = 0; kk < NCTX; ++kk) { const bf16_t* kp = P + (size_t)(SEQ + kk) * OD_IN + 512 + h * 64; osm_key(S, kp, kp + 512, 0.f); }
        osm_store(S, MX + (size_t)row * DM + h * 64);
    }
    const float* DW = a->in[I_DDW] + (size_t)i * 31 * 512; const float* DB = a->in[I_DDWB] + i * 512;
    const float* LG = a->in[I_DLNG] + i * 512; const float* LB = a->in[I_DLNB] + i * 512;
    for (int row = F.gw; row < NTOK; row += F.NGW) {
        const int lo = row < SEQ ? 0 : SEQ, hi = row < SEQ ? SEQ : NTOK, ch = 8 * F.lane;
        float acc[8];
#pragma unroll
        for (int j = 0; j < 8; ++j) acc[j] = DB[ch + j];
        for (int w = 0; w < 31; ++w) { const int tt = row + w - 15; if (tt < lo || tt >= hi) continue;
            float y[8]; unpack8(*(const bf16x8*)(P + (size_t)tt * OD_IN + 1536 + ch), y);
            const f32x4 w0 = *(const f32x4*)(DW + w * 512 + ch), w1 = *(const f32x4*)(DW + w * 512 + ch + 4);
            acc[0] += y[0] * w0.x; acc[1] += y[1] * w0.y; acc[2] += y[2] * w0.z; acc[3] += y[3] * w0.w; acc[4] += y[4] * w1.x; acc[5] += y[5] * w1.y; acc[6] += y[6] * w1.z; acc[7] += y[7] * w1.w; }
        float s = 0.f;
#pragma unroll
        for (int j = 0; j < 8; ++j) s += acc[j];
        const float mean = wave_sum(s) * (1.f / 512.f); float q = 0.f;
#pragma unroll
        for (int j = 0; j < 8; ++j) { acc[j] -= mean; q += acc[j] * acc[j]; }
        const float rstd = rsqrtf(wave_sum(q) * (1.f / 512.f) + EPS);
#pragma unroll
        for (int j = 0; j < 8; ++j) acc[j] = siluf_(acc[j] * rstd * LG[ch + j] + LB[ch + j]);
        *(u32x4*)(MX + (size_t)row * DM + 512 + ch) = pack8(acc);
    }
}

DEV void phase_norm2(KArgsP a, const Fr& F, int l) {
    const int ntok = l < DEPTH - 1 ? NTOK : SEQ, rpw = (ntok + F.G - 1) / F.G;
    LAS float* rwt = (LAS float*)F.lds;
    LAS int* le = (LAS int*)(F.lds + 65536);
    for (int e = F.tid; e < 16384; e += NTHR) rwt[(e & 15) * 1024 + (e >> 4)] = a->in[I_RW][e];
    __syncthreads();
    bf16_t* H = (bf16_t*)(a->ws + WS_H); TokInfo* TI = (TokInfo*)(a->ws + WS_TOK);
    const int r0 = F.bid * rpw, r1 = (r0 + rpw < ntok) ? r0 + rpw : ntok;
    for (int row = r0 + F.wave; row < r1; row += NWAVES) {
        const float* xr = xrow_out(a, row); f32x4 v[4]; float s = 0.f;
#pragma unroll
        for (int j = 0; j < 4; ++j) { v[j] = ((const f32x4*)xr)[64 * j + F.lane]; s += (v[j].x * v[j].x + v[j].y * v[j].y) + (v[j].z * v[j].z + v[j].w * v[j].w); }
        const float rstd = rsqrtf(wave_sum(s) * (1.f / DM) + EPS);
        const float* g = a->in[I_N2G] + l * DM; const float* sc = modp(a, l, row, 4); const float* sh = modp(a, l, row, 3);
        float lg[16];
#pragma unroll
        for (int e = 0; e < 16; ++e) lg[e] = 0.f;
#pragma unroll
        for (int j = 0; j < 4; ++j) { const int c4 = 64 * j + F.lane; const f32x4 G = ((const f32x4*)g)[c4], SC = ((const f32x4*)sc)[c4], SH = ((const f32x4*)sh)[c4];
            const f32x4 o = v[j] * rstd * G * (SC + 1.f) + SH; u32x2 w; w.x = pk2(o.x, o.y); w.y = pk2(o.z, o.w); ((u32x2*)(H + (size_t)row * DM))[c4] = w;
#pragma unroll
            for (int e = 0; e < 16; ++e) { const f32x4 rw = *(const LAS f32x4*)(rwt + e * 1024 + 4 * c4); lg[e] += (o.x * rw.x + o.y * rw.y) + (o.z * rw.z + o.w * rw.w); } }
        float aff[16], sel[16];
#pragma unroll
        for (int e = 0; e < 16; ++e) { aff[e] = sigmoidf_(wave_sum(lg[e])); sel[e] = aff[e] + a->in[I_RB][e]; }
        int bg = 0; float bgs = -1e30f;
#pragma unroll
        for (int gq = 0; gq < 4; ++gq) { float m1 = -1e30f, m2 = -1e30f;
#pragma unroll
            for (int k = 0; k < 4; ++k) { const float x = sel[gq * 4 + k]; if (x > m1) { m2 = m1; m1 = x; } else if (x > m2) m2 = x; }
            const float gs = m1 + m2; if (gs > bgs) { bgs = gs; bg = gq; } }
        int e0 = 0, e1 = 0; float s0 = -1e30f, s1 = -1e30f, a0 = 0.f, a1 = 0.f;
#pragma unroll
        for (int e = 0; e < 16; ++e) { if ((e >> 2) == bg) { const float x = sel[e]; if (x > s0) { s1 = s0; e1 = e0; a1 = a0; s0 = x; e0 = e; a0 = aff[e]; } else if (x > s1) { s1 = x; e1 = e; a1 = aff[e]; } } }
        if (F.lane == 0) { const float inv = 1.f / (a0 + a1); TI[row].e0 = e0; TI[row].e1 = e1; TI[row].w0 = a0 * inv; TI[row].w1 = a1 * inv; le[row - r0] = e0; le[rpw + row - r0] = e1; }
    }
    __syncthreads();
    if (F.tid < 16) { const int e = F.tid; int cnt = 0;
        for (int j = 0; j < r1 - r0; ++j) { if (le[j] == e) TI[r0 + j].r0 = cnt++; else if (le[rpw + j] == e) TI[r0 + j].r1 = cnt++; }
        ((int*)(a->ws + WS_CNT))[F.bid * 16 + e] = cnt; }
}

DEV void phase_gather(KArgsP a, const Fr& F, int l) {
    const int ntok = l < DEPTH - 1 ? NTOK : SEQ, rpw = (ntok + F.G - 1) / F.G;
    LAS int* sb = (LAS int*)F.lds;
    const int* cnt = (const int*)(a->ws + WS_CNT);
    if (F.tid < 48) sb[F.tid] = 0;
    __syncthreads();
    { const int e = F.tid & 15; int base = 0, tot = 0;
      for (int w = F.tid >> 4; w < F.G; w += NTHR / 16) { const int c = cnt[w * 16 + e]; base += (w < F.bid) ? c : 0; tot += c; }
      atomicAdd((int*)(sb + e), base); atomicAdd((int*)(sb + 16 + e), tot); }
    __syncthreads();
    if (F.tid < 16) { int ps = 0;
#pragma unroll
        for (int e = 0; e < 16; ++e) { const int pc = (sb[16 + e] + 255) & ~255; if (e < F.tid) ps += pc; }
        sb[32 + F.tid] = ps; }
    __syncthreads();
    if (F.bid == 0 && F.tid <= MAXBLK) { int* blk = (int*)(a->ws + WS_BLK); const int b = F.tid - 1;
        const int pend15 = sb[32 + 15] + ((sb[16 + 15] + 255) & ~255);
        if (F.tid == 0) blk[0] = pend15 >> 8;
        else if (b * 256 < pend15) { int e = 0;
#pragma unroll
            for (int q = 1; q < 16; ++q) e += (sb[32 + q] <= b * 256) ? 1 : 0;
            blk[1 + b] = e; } }
    const bf16_t* H = (const bf16_t*)(a->ws + WS_H); bf16_t* BUF = (bf16_t*)(a->ws + WS_BUF); TokInfo* TI = (TokInfo*)(a->ws + WS_TOK);
    const int r0 = F.bid * rpw, r1 = (r0 + rpw < ntok) ? r0 + rpw : ntok;
    for (int row = r0 + F.wave; row < r1; row += NWAVES) {
        const TokInfo ti = TI[row];
        const int d0 = sb[32 + ti.e0] + sb[ti.e0] + ti.r0, d1 = sb[32 + ti.e1] + sb[ti.e1] + ti.r1;
        if (F.lane == 0) { TI[row].d0 = d0; TI[row].d1 = d1; }
        const u32x4* src = (const u32x4*)(H + (size_t)row * DM); const u32x4 v0 = src[F.lane], v1 = src[64 + F.lane];
        u32x4* q0 = (u32x4*)(BUF + (size_t)d0 * DM); u32x4* q1 = (u32x4*)(BUF + (size_t)d1 * DM);
        q0[F.lane] = v0; q0[64 + F.lane] = v1; q1[F.lane] = v0; q1[64 + F.lane] = v1;
    }
}

DEV void phase_gu_simple(KArgsP a, const Fr& F, int l) {
    const int* blk = (const int*)(a->ws + WS_BLK); const int nblk = blk[0];
    const bf16_t* BUF = (const bf16_t*)(a->ws + WS_BUF); bf16_t* ACT = (bf16_t*)(a->ws + WS_ACT);
    const int r32 = F.lane & 31, hi = F.lane >> 5;
    for (int t = F.gw; t < nblk * 128; t += F.NGW) {
        const int b = t >> 7, q = t & 127, mt = q >> 4, ct = q & 15, e = blk[1 + b];
        const bf16_t* W = (const bf16_t*)(a->ws + WS_WGU) + (size_t)(l * 16 + e) * 1024 * 1024;
        const int m0 = b * 256 + mt * 32, c0 = ct * 32, ng = 256 * (c0 / 128) + (c0 % 128);
        f32x16 ag = {}, au = {};
        const bf16_t* ap = BUF + (size_t)(m0 + r32) * DM + 8 * hi; const bf16_t* gp = W + (size_t)(ng + r32) * DM + 8 * hi; const bf16_t* up = gp + (size_t)128 * DM;
        for (int k = 0; k < DM; k += 16) { const bf16x8 av = *(const bf16x8*)(ap + k);
            ag = __builtin_amdgcn_mfma_f32_32x32x16_bf16(av, *(const bf16x8*)(gp + k), ag, 0, 0, 0); au = __builtin_amdgcn_mfma_f32_32x32x16_bf16(av, *(const bf16x8*)(up + k), au, 0, 0, 0); }
#pragma unroll
        for (int r = 0; r < 16; ++r) { const int row = m0 + (r & 3) + 8 * (r >> 2) + 4 * hi; ACT[(size_t)row * DEXP + c0 + r32] = (bf16_t)f2bf(siluf_(ag[r]) * au[r]); }
    }
}
DEV void phase_down_simple(KArgsP a, const Fr& F, int l) {
    const int* blk = (const int*)(a->ws + WS_BLK); const int nblk = blk[0];
    const bf16_t* ACT = (const bf16_t*)(a->ws + WS_ACT); bf16_t* Y = (bf16_t*)(a->ws + WS_P);
    const int r32 = F.lane & 31, hi = F.lane >> 5;
    for (int t = F.gw; t < nblk * 256; t += F.NGW) {
        const int b = t >> 8, q = t & 255, mt = q >> 5, nt = q & 31, e = blk[1 + b];
        const bf16_t* W = (const bf16_t*)(a->ws + WS_WDN) + (size_t)(l * 16 + e) * 1024 * 512;
        const int m0 = b * 256 + mt * 32, n0 = nt * 32; f32x16 acc = {};
        const bf16_t* ap = ACT + (size_t)(m0 + r32) * DEXP + 8 * hi; const bf16_t* bp = W + (size_t)(n0 + r32) * DEXP + 8 * hi;
        for (int k = 0; k < DEXP; k += 16) acc = __builtin_amdgcn_mfma_f32_32x32x16_bf16(*(const bf16x8*)(ap + k), *(const bf16x8*)(bp + k), acc, 0, 0, 0);
#pragma unroll
        for (int r = 0; r < 16; ++r) { const int row = m0 + (r & 3) + 8 * (r >> 2) + 4 * hi; Y[(size_t)row * DM + n0 + r32] = (bf16_t)f2bf(acc[r]); }
    }
}

DEV void phase_comb(KArgsP a, const Fr& F, int l) {
    const int ntok = l < DEPTH - 1 ? NTOK : SEQ;
    const bf16_t* Y = (const bf16_t*)(a->ws + WS_P); const TokInfo* TI = (const TokInfo*)(a->ws + WS_TOK); bf16_t* H = (bf16_t*)(a->ws + WS_H);
    for (int row = F.gw; row < ntok; row += F.NGW) {
        const TokInfo ti = TI[row]; float* xr = xrow_out(a, row); const float* g2 = modp(a, l, row, 5);
        const u32x2* y0 = (const u32x2*)(Y + (size_t)ti.d0 * DM); const u32x2* y1 = (const u32x2*)(Y + (size_t)ti.d1 * DM);
        f32x4 v[4];
#pragma unroll
        for (int j = 0; j < 4; ++j) { const int c4 = 64 * j + F.lane; const f32x4 x = ((const f32x4*)xr)[c4], G = ((const f32x4*)g2)[c4]; const u32x2 p0 = y0[c4], p1 = y1[c4];
            f32x4 f; f.x = ti.w0 * __uint_as_float(p0.x << 16) + ti.w1 * __uint_as_float(p1.x << 16); f.y = ti.w0 * __uint_as_float(p0.x & 0xffff0000u) + ti.w1 * __uint_as_float(p1.x & 0xffff0000u);
            f.z = ti.w0 * __uint_as_float(p0.y << 16) + ti.w1 * __uint_as_float(p1.y << 16); f.w = ti.w0 * __uint_as_float(p0.y & 0xffff0000u) + ti.w1 * __uint_as_float(p1.y & 0xffff0000u);
            v[j] = x + G * f; ((f32x4*)xr)[c4] = v[j]; }
        if (l < DEPTH - 1) modnorm_regs(v, a->in[I_N1G] + (l + 1) * DM, modp(a, l + 1, row, 1), modp(a, l + 1, row, 0), H + (size_t)row * DM, F.lane);
    }
}

#define XB_TMO      128
#define XB_XCNT(j)  (256  + 64 * (j))
#define XB_XSUB(j)  (1280 + 64 * (j))
#define XB_XGEN(j)  (2304 + 64 * (j))
#define XB_TOP      3328
#define XB_TOPGEN   3392
#define XCD_BAR_WORDS 3456
#define XB_SPIN_CAP (1u << 22)
DEV unsigned xb_ld(unsigned* p)              { return __hip_atomic_load(p, __ATOMIC_RELAXED, __HIP_MEMORY_SCOPE_AGENT); }
DEV unsigned xb_add(unsigned* p, unsigned v) { return __hip_atomic_fetch_add(p, v, __ATOMIC_RELAXED, __HIP_MEMORY_SCOPE_AGENT); }
DEV unsigned xb_xcc_id() { return (unsigned)__builtin_amdgcn_s_getreg((3 << 11) | 20) & 0xFu; }
#define XB_SPIN(cond, bar) do { unsigned _sp = 0; while (cond) { __builtin_amdgcn_s_sleep(1); \
    if ((++_sp & 255u) == 0u) { if (xb_ld(&(bar)[XB_TMO])) break; if (_sp > XB_SPIN_CAP) { atomicAdd(&(bar)[XB_TMO], 1u); break; } } } } while (0)
struct XcdBarrier { unsigned* bar; unsigned x; volatile LAS unsigned* st; };
DEV XcdBarrier xcd_barrier_post(unsigned* bar, volatile LAS unsigned* st) {
    XcdBarrier b; b.bar = bar; b.x = xb_xcc_id(); b.st = st;
    if (threadIdx.x == 0) (void)xb_add(&bar[XB_XCNT(b.x)], 1u);
    return b;
}
DEV void xcd_barrier_complete(unsigned* bar, unsigned x, unsigned& nloc, unsigned& nx) {
    const unsigned G = gridDim.x * gridDim.y * gridDim.z;
    unsigned sum, cnt, mine, sp = 0u;
    for (;;) {
        sum = 0u; cnt = 0u; mine = 0u;
#pragma unroll
        for (unsigned j = 0; j < 16; ++j) { const unsigned c = xb_ld(&bar[XB_XCNT(j)]); sum += c; cnt += (c > 0u) ? 1u : 0u; mine = (j == x) ? c : mine; }
        if (sum == G) break;
        __builtin_amdgcn_s_sleep(1);
        if ((++sp & 255u) == 0u) { if (xb_ld(&bar[XB_TMO])) break; if (sp > XB_SPIN_CAP) { atomicAdd(&bar[XB_TMO], 1u); break; } }
    }
    nloc = mine > 0u ? mine : 1u; nx = cnt > 0u ? cnt : 1u;
}
DEV void xcd_barrier(const XcdBarrier& b) {
    asm volatile("s_waitcnt vmcnt(0)" ::: "memory");
    __syncthreads();
    if (threadIdx.x == 0) {
        unsigned* bar = b.bar;
        __builtin_amdgcn_s_waitcnt(0);
        unsigned nloc = b.st[0], nx = b.st[1];
        if (nloc == 0u) { xcd_barrier_complete(bar, b.x, nloc, nx); b.st[0] = nloc; b.st[1] = nx; }
        const unsigned old = xb_add(&bar[XB_XSUB(b.x)], 1u);
        const unsigned gen = old / nloc;
        if (old + 1u == (gen + 1u) * nloc) {
            __builtin_amdgcn_fence(__ATOMIC_RELEASE, "agent");
            asm volatile("s_waitcnt vmcnt(0)" ::: "memory");
            const unsigned og = xb_add(&bar[XB_TOP], 1u);
            const unsigned tg = og / nx;
            if (og + 1u == (tg + 1u) * nx) xb_add(&bar[XB_TOPGEN], 1u);
            else XB_SPIN(xb_ld(&bar[XB_TOPGEN]) == tg, bar);
            __builtin_amdgcn_fence(__ATOMIC_ACQUIRE, "agent");
            xb_add(&bar[XB_XGEN(b.x)], 1u);
            asm volatile("s_waitcnt vmcnt(0)" ::: "memory");
        } else {
            XB_SPIN(xb_ld(&bar[XB_XGEN(b.x)]) == gen, bar);
            __builtin_amdgcn_fence(__ATOMIC_ACQUIRE, "agent");
            asm volatile("s_waitcnt vmcnt(0)" ::: "memory");
        }
    }
    __syncthreads();
}

constexpr int NPH = 2 + 9 * DEPTH;
__global__ void __launch_bounds__(NTHR, 2) mega(KArgs a_unused) {
    extern __shared__ __attribute__((aligned(16))) unsigned char lds_raw[];
#define FRAME() Fr F; { int t_ = threadIdx.x; asm volatile("" : "+v"(t_)); int b_ = blockIdx.x; asm volatile("" : "+s"(b_)); F.tid = t_; F.lane = t_ & 63; F.wave = __builtin_amdgcn_readfirstlane(t_ >> 6); F.bid = b_; F.G = gridDim.x; \
      F.gw = F.bid * NWAVES + F.wave; F.NGW = F.G * NWAVES; F.lds = (LAS unsigned char*)lds_raw; }
#define IN(k) (lo <= (k) && (k) < hi)
    int lo, hi; XcdBarrier bar;
    { KArgsP a = kargs(); lo = a->ph_lo; hi = a->ph_hi;
      volatile LAS unsigned* st = (volatile LAS unsigned*)((LAS unsigned char*)lds_raw + LDS_BYTES - 64);
      if (threadIdx.x < 16) st[threadIdx.x] = 0u;
      __syncthreads();
      bar = xcd_barrier_post((unsigned*)(a->ws + WS_CTL) + 4096, st); }
#define SEAM(k) do { if ((k) + 1 < hi) xcd_barrier(bar); } while (0)
    if (IN(0)) { FRAME(); phase_pro_a(kargs(), F); SEAM(0); }
    if (IN(1)) { FRAME(); phase_pro_b(kargs(), F); SEAM(1); }
    for (int l = 0; l < DEPTH; ++l) {
        const int pb = 2 + 9 * l, i = l >> 1; const bool even = (l & 1) == 0;
        if (IN(pb + 0)) { FRAME(); KArgsP a = kargs();
            const bf16_t* Hh = (const bf16_t*)(a->ws + WS_H); bf16_t* Pp = (bf16_t*)(a->ws + WS_P);
            const bf16_t* Wt = even ? (const bf16_t*)(a->ws + WS_WEVIN) + (size_t)i * EV_IN * DM : (const bf16_t*)(a->ws + WS_WODIN) + (size_t)i * OD_IN * DM;
            const int N = even ? EV_IN : OD_IN;
            { pg8::Gemm g{Hh, Wt, SEQ, N, DM}; pg8::StaticOrder S; S.init(SEQ, N, F.G, F.bid); pg8::EpiBf16 E{Pp, N};
              pg8::gemm_phase<pg8::EpiBf16, pg8::StaticOrder, true, true>(F.lds, g, S, E, F.tid); }
            gemm_simple(Hh + (size_t)SEQ * DM, Wt, NCTX, N, DM, EpiP{Pp, N}, F, SEQ);
            SEAM(pb + 0); }
        if (IN(pb + 1)) { FRAME(); if (even) phase_pre_even(kargs(), F, i); else phase_pre_odd(kargs(), F, i); SEAM(pb + 1); }
        if (IN(pb + 2)) { FRAME(); if (even) phase_mix_even(kargs(), F, i); else phase_mix_odd(kargs(), F, i); SEAM(pb + 2); }
        if (IN(pb + 3)) { FRAME(); KArgsP a = kargs();
            const bf16_t* Mm = (const bf16_t*)(a->ws + WS_MX); const bf16_t* Wt = (const bf16_t*)(a->ws + (even ? WS_WEVOUT : WS_WODOUT)) + (size_t)i * DM * DM;
            { pg8::Gemm g{Mm, Wt, SEQ, DM, DM}; pg8::StaticOrder S; S.init(SEQ, DM, F.G, F.bid); pg8::EpiResF32 E{xrow_in(a, l, 0), a->out, modp(a, l, 0, 2)};
              pg8::gemm_phase<pg8::EpiResF32, pg8::StaticOrder, true, true>(F.lds, g, S, E, F.tid); }
            gemm_simple(Mm + (size_t)SEQ * DM, Wt, NCTX, DM, DM, EpiRes{a, l}, F, SEQ);
            SEAM(pb + 3); }
        if (IN(pb + 4)) { FRAME(); phase_norm2(kargs(), F, l); SEAM(pb + 4); }
        if (IN(pb + 5)) { FRAME(); phase_gather(kargs(), F, l); SEAM(pb + 5); }
        if (IN(pb + 6)) { FRAME(); KArgsP a = kargs(); const int* blk = (const int*)(a->ws + WS_BLK);
            const int nblk = __builtin_amdgcn_readfirstlane((int)__hip_atomic_load((const unsigned*)blk, __ATOMIC_RELAXED, __HIP_MEMORY_SCOPE_AGENT));
            pg8::Gemm g{(const bf16_t*)(a->ws + WS_BUF), (const bf16_t*)(a->ws + WS_WGU) + (size_t)l * 16 * 1024 * 1024, nblk * 256, 1024, DM};
            pg8::GroupedOrder S{nblk * 4, F.G, F.bid, 4, blk, 2l * 1024 * 1024}; pg8::EpiGU E{(bf16_t*)(a->ws + WS_ACT)};
            pg8::gemm_phase<pg8::EpiGU, pg8::GroupedOrder, true, true>(F.lds, g, S, E, F.tid);
            SEAM(pb + 6); }
        if (IN(pb + 7)) { FRAME(); KArgsP a = kargs(); const int* blk = (const int*)(a->ws + WS_BLK);
            const int nblk = __builtin_amdgcn_readfirstlane((int)__hip_atomic_load((const unsigned*)blk, __ATOMIC_RELAXED, __HIP_MEMORY_SCOPE_AGENT));
            pg8::Gemm g{(const bf16_t*)(a->ws + WS_ACT), (const bf16_t*)(a->ws + WS_WDN) + (size_t)l * 16 * 1024 * 512, nblk * 256, 1024, DEXP};
            pg8::GroupedOrder S{nblk * 4, F.G, F.bid, 4, blk, 1l * 1024 * 1024}; pg8::EpiBf16 E{(bf16_t*)(a->ws + WS_P), DM};
            pg8::gemm_phase<pg8::EpiBf16, pg8::GroupedOrder, true, true>(F.lds, g, S, E, F.tid);
            SEAM(pb + 7); }
        if (IN(pb + 8)) { FRAME(); phase_comb(kargs(), F, l); SEAM(pb + 8); }
    }
#undef IN
#ifdef DBG_STOP
    { FRAME(); KArgsP a = kargs(); xcd_barrier(bar); const bf16_t* src = (const bf16_t*)(a->ws + DBG_SRC); float* o = a->out;
      for (size_t i = (size_t)F.bid * NTHR + F.tid; i < (size_t)SEQ * DM; i += (size_t)F.G * NTHR) o[i] = bf2f(src[i]); }
#endif
}

extern "C" void kernel_launch(void* const* d_in, const int* in_sizes, int n_in, void* d_out, int out_size, void* d_ws, size_t ws_size, hipStream_t stream) {
    static int grid = 0;
    if (grid == 0) {
        if (n_in != 29 || out_size != SEQ * DM || ws_size < WS_END) { fprintf(stderr, "kernel_launch: unexpected problem (n_in %d, out %d, ws %zu)\n", n_in, out_size, ws_size); grid = -1; return; }
        int dev = 0, cus = 0, per_cu = 0;
        if (hipGetDevice(&dev) != hipSuccess || hipDeviceGetAttribute(&cus, hipDeviceAttributeMultiprocessorCount, dev) != hipSuccess) { grid = -1; return; }
        if (hipFuncSetAttribute((const void*)mega, hipFuncAttributeMaxDynamicSharedMemorySize, LDS_BYTES) != hipSuccess) { fprintf(stderr, "kernel_launch: hipFuncSetAttribute failed\n"); grid = -1; return; }
        if (hipOccupancyMaxActiveBlocksPerMultiprocessor(&per_cu, (const void*)mega, NTHR, LDS_BYTES) != hipSuccess || per_cu < 1) { fprintf(stderr, "kernel_launch: occupancy query says %d\n", per_cu); (void)hipGetLastError(); }
        grid = cus;
    }
    if (grid < 0) return;
    KArgs a{};
    for (int i = 0; i < 29; ++i) a.in[i] = (const float*)d_in[i];
    a.out = (float*)d_out; a.ws = (unsigned char*)d_ws;
    (void)hipMemsetAsync((char*)d_ws + WS_CTL, 0, CTL_BYTES, stream);
#if N_LAUNCHES == 1
    a.ph_lo = 0; a.ph_hi = NPH; hipLaunchKernelGGL(mega, dim3(grid), dim3(NTHR), LDS_BYTES, stream, a);
#else
    for (int ph = 0; ph < NPH; ++ph) { a.ph_lo = ph; a.ph_hi = ph + 1; hipLaunchKernelGGL(mega, dim3(grid), dim3(NTHR), LDS_BYTES, stream, a); }
#endif
}
```

```cpp
#include <hip/hip_runtime.h>
#include <hip/hip_bf16.h>
#include <cmath>
#include <cstdint>
#include <cstdio>

#define DEV __device__ __forceinline__
#define LAS __attribute__((address_space(3)))
typedef unsigned short bf16_t;
typedef short bf16x8 __attribute__((ext_vector_type(8)));
typedef float f32x4 __attribute__((ext_vector_type(4)));
typedef float f32x2 __attribute__((ext_vector_type(2)));
typedef float f32x16 __attribute__((ext_vector_type(16)));
typedef unsigned u32x4 __attribute__((ext_vector_type(4)));
typedef unsigned u32x2 __attribute__((ext_vector_type(2)));

constexpr int DM = 1024, SEQ = 16384, NCTX = 256, NTOK = SEQ + NCTX, DEPTH = 4, GRIDW = 64;
constexpr int EV_IN = 1792, OD_IN = 2560, NEXP = 16, DEXP = 512;
constexpr int MAXBLK = 146;
constexpr float EPS = 1e-6f;
constexpr float ATT_C2 = 0.125f * 1.4426950408889634f;
constexpr int NWAVES = 8, NTHR = 512;

constexpr size_t MiB = 1u << 20;
constexpr size_t WS_CTL = 0, CTL_BYTES = 1 * MiB;
constexpr size_t WS_MOD = 1 * MiB;
constexpr size_t WS_ROPE = 1 * MiB + 256 * 1024;
constexpr size_t WS_CNT = 1 * MiB + 512 * 1024;
constexpr size_t WS_BLK = 1 * MiB + 768 * 1024;
constexpr size_t WS_TOK = 2 * MiB;
constexpr size_t WS_XCTX = 3 * MiB;
constexpr size_t WS_WEVIN = 4 * MiB;
constexpr size_t WS_WEVOUT = 11 * MiB;
constexpr size_t WS_WODIN = 15 * MiB;
constexpr size_t WS_WODOUT = 25 * MiB;
constexpr size_t WS_BWS = 29 * MiB;
constexpr size_t WS_WGU = 30 * MiB;
constexpr size_t WS_WDN = 158 * MiB;
constexpr size_t WS_H = 222 * MiB;
constexpr size_t WS_P = 255 * MiB;
constexpr size_t WS_MX = 337 * MiB;
constexpr size_t WS_BUF = 370 * MiB;
constexpr size_t WS_ACT = 443 * MiB;
constexpr size_t WS_END = 480 * MiB;
static_assert(WS_H + (size_t)NTOK * DM * 2 <= WS_P && WS_P + (size_t)NTOK * OD_IN * 2 <= WS_MX && WS_P + (size_t)MAXBLK * 256 * DM * 2 <= WS_MX, "ws map");
static_assert(WS_MX + (size_t)NTOK * DM * 2 <= WS_BUF && WS_BUF + (size_t)MAXBLK * 256 * DM * 2 <= WS_ACT && WS_ACT + (size_t)MAXBLK * 256 * DEXP * 2 <= WS_END, "ws map");

constexpr int LDS_BYTES = 147456;
#define REP_S -1
#define REPS(s) for (int rr_ = 0; rr_ < ((REP_S) == (s) ? 2 : 1); ++rr_)
#ifndef N_LAUNCHES
#define N_LAUNCHES 1
#endif

struct TokInfo { int e0, e1; float w0, w1; int r0, r1, d0, d1; };
struct KArgs { const float* in[29]; float* out; unsigned char* ws; int ph_lo, ph_hi; };
enum { I_X = 0, I_C, I_CTX, I_CCTX, I_RW, I_RB, I_ADAW, I_ADAB, I_N1G, I_N2G, I_EVIN, I_EVOUT, I_AQN, I_AKN, I_BVN, I_BWS, I_BBS,
       I_ODIN, I_ODOUT, I_CQN, I_CKN, I_RPB, I_DDW, I_DDWB, I_DLNG, I_DLNB, I_MG, I_MU, I_MD };

DEV float bf2f(bf16_t v) { return __uint_as_float((unsigned)v << 16); }
DEV float bf2f_s(short v) { return __uint_as_float(((unsigned)(unsigned short)v) << 16); }
DEV unsigned f2bf(float f) { unsigned u = __float_as_uint(f); return (u + 0x7fffu + ((u >> 16) & 1u)) >> 16; }
DEV unsigned pk2(float lo, float hi) { return f2bf(lo) | (f2bf(hi) << 16); }
DEV float wave_sum(float v) {
#pragma unroll
    for (int o = 1; o < 64; o <<= 1) v += __shfl_xor(v, o);
    return v;
}
DEV float sigmoidf_(float x) { return 1.f / (1.f + __expf(-x)); }
DEV float siluf_(float x) { return x / (1.f + __expf(-x)); }
DEV float gelu_tanh(float x) { const float u = 0.7978845608028654f * (x + 0.044715f * x * x * x); const float t = 1.f - 2.f / (__expf(2.f * u) + 1.f); return 0.5f * x * (1.f + t); }
DEV void unpack8(const bf16x8 v, float* f) {
#pragma unroll
    for (int j = 0; j < 8; ++j) f[j] = bf2f_s(v[j]);
}
DEV u32x4 pack8(const float* f) { u32x4 o; o.x = pk2(f[0], f[1]); o.y = pk2(f[2], f[3]); o.z = pk2(f[4], f[5]); o.w = pk2(f[6], f[7]); return o; }

typedef const __attribute__((address_space(4))) KArgs* KArgsP;
DEV KArgsP kargs() { KArgsP p = (KArgsP)__builtin_amdgcn_kernarg_segment_ptr(); asm volatile("" : "+s"(p)); return p; }
struct Fr { int tid, lane, wave, bid, G, gw, NGW; LAS unsigned char* lds; };

DEV const float* xrow_in(KArgsP a, int l, int row) {
    if (l == 0) return row < SEQ ? a->in[I_X] + (size_t)row * DM : a->in[I_CTX] + (size_t)(row - SEQ) * DM;
    return row < SEQ ? a->out + (size_t)row * DM : (const float*)(a->ws + WS_XCTX) + (size_t)(row - SEQ) * DM;
}
DEV float* xrow_out(KArgsP a, int row) { return row < SEQ ? a->out + (size_t)row * DM : (float*)(a->ws + WS_XCTX) + (size_t)(row - SEQ) * DM; }
DEV const float* modp(KArgsP a, int l, int row, int j) { return (const float*)(a->ws + WS_MOD) + (size_t)(l * 2 + (row < SEQ ? 0 : 1)) * 6144 + j * 1024; }

DEV void transpose_item(const float* W, int K, int N, int k0, int n0, bf16_t* drow0, LAS float* scr, int lane) {
#pragma unroll 8
    for (int i = 0; i < 32; ++i) { const int kk = 2 * i + (lane >> 5); scr[kk * 33 + (lane & 31)] = W[(size_t)(k0 + kk) * N + n0 + (lane & 31)]; }
    asm volatile("s_waitcnt lgkmcnt(0)" ::: "memory");
    const int c = lane & 7;
#pragma unroll
    for (int j = 0; j < 4; ++j) { const int n = (lane >> 3) + 8 * j; const LAS float* s = scr + (8 * c) * 33 + n;
        u32x4 o; o.x = pk2(s[0 * 33], s[1 * 33]); o.y = pk2(s[2 * 33], s[3 * 33]); o.z = pk2(s[4 * 33], s[5 * 33]); o.w = pk2(s[6 * 33], s[7 * 33]);
        *(u32x4*)(drow0 + (size_t)n * K + k0 + 8 * c) = o; }
    asm volatile("s_waitcnt lgkmcnt(0)" ::: "memory");
}

DEV void phase_pro_a(KArgsP a, const Fr& F) {
    LAS float* sl = (LAS float*)F.lds;
    LAS float* red = sl + 2048;
    float* mod = (float*)(a->ws + WS_MOD);
    bool loaded = false;
    for (int it = F.bid; it < 96; it += F.G) {
        if (!loaded) {
            for (int i = F.tid; i < 2048; i += NTHR) { const float v = i < 1024 ? a->in[I_C][i] : a->in[I_CCTX][i - 1024]; sl[i] = siluf_(v); }
            __syncthreads(); loaded = true;
        }
        const int l = it / 24, cg = it % 24, n0 = cg * 256 + 4 * F.lane;
        const float* W = a->in[I_ADAW] + (size_t)l * 1024 * 6144 + n0;
        f32x4 a0 = {0.f, 0.f, 0.f, 0.f}, a1 = {0.f, 0.f, 0.f, 0.f};
        const int kb = F.wave * 128;
#pragma unroll 8
        for (int k = 0; k < 128; ++k) { const f32x4 w = *(const f32x4*)(W + (size_t)(kb + k) * 6144); a0 += w * sl[kb + k]; a1 += w * sl[1024 + kb + k]; }
#pragma unroll
        for (int j = 0; j < 4; ++j) { red[(F.wave * 2 + 0) * 256 + 4 * F.lane + j] = a0[j]; red[(F.wave * 2 + 1) * 256 + 4 * F.lane + j] = a1[j]; }
        __syncthreads();
        { const int s = F.tid >> 8, n = F.tid & 255; float sum = a->in[I_ADAB][l * 6144 + cg * 256 + n];
#pragma unroll
          for (int w = 0; w < 8; ++w) sum += red[(w * 2 + s) * 256 + n];
          mod[(size_t)(l * 2 + s) * 6144 + cg * 256 + n] = sum; }
        __syncthreads();
    }
    if (F.bid == F.G - 1) {
        f32x2* tab = (f32x2*)(a->ws + WS_ROPE);
        for (int i = F.tid; i < 256 * 16; i += NTHR) { const int pos = i >> 4, f = i & 15;
            const float inv = exp2f(-(float)f * (13.287712379549449f / 16.f)); const float ang = (float)pos * inv;
            double rev = (double)ang * 0.15915494309189535; rev -= floor(rev); const float r = (float)rev;
            tab[i] = (f32x2){__builtin_amdgcn_cosf(r), __builtin_amdgcn_sinf(r)}; }
    }
    LAS float* scr = (LAS float*)(F.lds + 32768 + F.wave * 8448);
    constexpr int T0 = 2 * 896, T1 = T0 + 2 * 512, T2 = T1 + 2 * 1280, T3 = T2 + 2 * 512, T4 = T3 + 64 * 256, T5 = T4 + 64 * 256, T6 = T5 + 64 * 256;
    for (int it = F.gw; it < T6; it += F.NGW) {
        if (it < T0) { const int i = it / 896, r = it % 896; transpose_item(a->in[I_EVIN] + (size_t)i * 1024 * EV_IN, 1024, EV_IN, 64 * (r / 56), 32 * (r % 56), (bf16_t*)(a->ws + WS_WEVIN) + (size_t)i * EV_IN * 1024 + (size_t)(32 * (r % 56)) * 1024, scr, F.lane); }
        else if (it < T1) { const int q = it - T0, i = q / 512, r = q % 512; transpose_item(a->in[I_EVOUT] + (size_t)i * 1024 * 1024, 1024, 1024, 64 * (r / 32), 32 * (r % 32), (bf16_t*)(a->ws + WS_WEVOUT) + (size_t)i * 1024 * 1024 + (size_t)(32 * (r % 32)) * 1024, scr, F.lane); }
        else if (it < T2) { const int q = it - T1, i = q / 1280, r = q % 1280; transpose_item(a->in[I_ODIN] + (size_t)i * 1024 * OD_IN, 1024, OD_IN, 64 * (r / 80), 32 * (r % 80), (bf16_t*)(a->ws + WS_WODIN) + (size_t)i * OD_IN * 1024 + (size_t)(32 * (r % 80)) * 1024, scr, F.lane); }
        else if (it < T3) { const int q = it - T2, i = q / 512, r = q % 512; transpose_item(a->in[I_ODOUT] + (size_t)i * 1024 * 1024, 1024, 1024, 64 * (r / 32), 32 * (r % 32), (bf16_t*)(a->ws + WS_WODOUT) + (size_t)i * 1024 * 1024 + (size_t)(32 * (r % 32)) * 1024, scr, F.lane); }
        else if (it < T5) { const bool up = it >= T4; const int q = it - (up ? T4 : T3), m = q / 256, r = q % 256, n0 = 32 * (r % 16);
            const int drow = 256 * (n0 / 128) + (up ? 128 : 0) + (n0 % 128);
            transpose_item(a->in[up ? I_MU : I_MG] + (size_t)m * 1024 * 512, 1024, 512, 64 * (r / 16), n0, (bf16_t*)(a->ws + WS_WGU) + (size_t)m * 1024 * 1024 + (size_t)drow * 1024, scr, F.lane); }
        else { const int q = it - T5, m = q / 256, r = q % 256, n0 = 32 * (r % 32);
            transpose_item(a->in[I_MD] + (size_t)m * 512 * 1024, 512, 1024, 64 * (r / 32), n0, (bf16_t*)(a->ws + WS_WDN) + (size_t)m * 1024 * 512 + (size_t)n0 * 512, scr, F.lane); }
    }
}

DEV void modnorm_regs(const f32x4 (&v)[4], const float* g, const float* sc, const float* sh, bf16_t* orow, int lane) {
    float s = 0.f;
#pragma unroll
    for (int j = 0; j < 4; ++j) s += (v[j].x * v[j].x + v[j].y * v[j].y) + (v[j].z * v[j].z + v[j].w * v[j].w);
    const float rstd = rsqrtf(wave_sum(s) * (1.f / DM) + EPS);
#pragma unroll
    for (int j = 0; j < 4; ++j) { const int c4 = 64 * j + lane; const f32x4 G = ((const f32x4*)g)[c4], SC = ((const f32x4*)sc)[c4], SH = ((const f32x4*)sh)[c4];
        const f32x4 o = v[j] * rstd * G * (SC + 1.f) + SH; u32x2 w; w.x = pk2(o.x, o.y); w.y = pk2(o.z, o.w); ((u32x2*)orow)[c4] = w; }
}

DEV void phase_pro_b(KArgsP a, const Fr& F) {
    bf16_t* H = (bf16_t*)(a->ws + WS_H);
    for (int row = F.gw; row < NTOK; row += F.NGW) {
        const float* xr = xrow_in(a, 0, row); f32x4 v[4];
#pragma unroll
        for (int j = 0; j < 4; ++j) v[j] = ((const f32x4*)xr)[64 * j + F.lane];
        modnorm_regs(v, a->in[I_N1G], modp(a, 0, row, 1), modp(a, 0, row, 0), H + (size_t)row * DM, F.lane);
    }
}

template <class Epi> DEV void gemm_simple(const bf16_t* A, const bf16_t* Bt, int M, int N, int K, const Epi& E, const Fr& F, int rowbase = 0) {
    const int ntn = N / 32, total = (M / 32) * ntn, r32 = F.lane & 31, hi = F.lane >> 5;
    for (int t = F.gw; t < total; t += F.NGW) {
        const int m0 = (t / ntn) * 32, n0 = (t % ntn) * 32;
        f32x16 acc = {};
        const bf16_t* ap = A + (size_t)(m0 + r32) * K + 8 * hi; const bf16_t* bp = Bt + (size_t)(n0 + r32) * K + 8 * hi;
        for (int k = 0; k < K; k += 16) acc = __builtin_amdgcn_mfma_f32_32x32x16_bf16(*(const bf16x8*)(ap + k), *(const bf16x8*)(bp + k), acc, 0, 0, 0);
#pragma unroll
        for (int r = 0; r < 16; ++r) E(rowbase + m0 + (r & 3) + 8 * (r >> 2) + 4 * hi, n0 + r32, acc[r]);
    }
}
struct EpiP { bf16_t* P; int ldc; DEV void operator()(int row, int col, float v) const { P[(size_t)row * ldc + col] = (bf16_t)f2bf(v); } };
struct EpiRes { KArgsP a; int l; DEV void operator()(int row, int col, float v) const { const float* xi = xrow_in(a, l, row); float* xo = xrow_out(a, row); xo[col] = xi[col] + modp(a, l, row, 2)[col] * v; } };

namespace pg8 {
#define PG8_LAS __attribute__((address_space(3)))
typedef unsigned short bf16_t;
typedef short bf16x8 __attribute__((ext_vector_type(8)));
typedef float f32x4 __attribute__((ext_vector_type(4)));
typedef unsigned u32x4 __attribute__((ext_vector_type(4)));
constexpr int BM = 256, BK = 64, HALF = 128, HTB = HALF * BK * 2  , STAGE_BYTES = 8 * HTB, NXCD = 8, WGM = 8;

__host__ __device__ __forceinline__ int lds_byte(int r, int c) { const int st = (r >> 4) * 2 + (c >> 5), rr = r & 15, cc = c & 31, ob = rr * 64 + cc * 2; return st * 1024 + (ob ^ (((ob >> 9) & 1) << 5)); }
__host__ __device__ __forceinline__ void stage_rc(int b, int& R, int& C) { const int st = b / 1024, sb = b % 1024, swz = sb ^ (((sb >> 9) & 1) << 5); R = (st >> 1) * 16 + swz / 64; C = (st & 1) * 32 + (swz % 64) / 2; }
__host__ __device__ __forceinline__ int perm32(int rho) { const int n = rho >> 4, i = rho & 15; return 8 * (i >> 2) + 4 * n + (i & 3); }

struct Unit { int pm, pn; long boff; };
struct Gemm { const bf16_t* A; const bf16_t* Bt; int M, N, K; };

struct StaticOrder {
    int nM, nN, nwg, G, c;
    __host__ __device__ void init(int M, int N, int G_, int c_) { nM = M / BM; nN = N / BM; nwg = nM * nN; G = G_; c = c_; }
    __host__ __device__ bool next(int i, Unit& u) const {
        const long L = (long)i * G + c; if (L >= nwg) return false;
        int wgid = (int)L; { const int q = nwg / NXCD, r = nwg % NXCD, xcd = wgid % NXCD, off = wgid / NXCD; wgid = (xcd < r ? xcd * (q + 1) : r * (q + 1) + (xcd - r) * q) + off; }
        const int nig = WGM * nN, gid = wgid / nig, fm = gid * WGM, gsz = (nM - fm) < WGM ? (nM - fm) : WGM;
        u.pm = fm + ((wgid % nig) % gsz); u.pn = (wgid % nig) / gsz; u.boff = 0; return true;
    }
    __device__ __forceinline__ void a_ready(const Unit&) const {}
    __device__ __forceinline__ void done(const Unit&) const {}
};


__device__ __forceinline__ unsigned cvt_pk_bf16(float lo, float hi) { unsigned r; asm volatile("v_cvt_pk_bf16_f32 %0, %1, %2" : "=v"(r) : "v"(lo), "v"(hi)); return r; }
struct EpiBf16 {
    static constexpr bool PERM = true, AFTER_DRAIN = false;
    bf16_t* O; int ldc;
    __device__ __forceinline__ void operator()(const f32x4 (&acc)[2][2][4][2], const Unit& u, int wr, int wc, int fr, int fq) const {
        const int row0 = u.pm * BM + wr * 64 + fr, col0 = u.pn * BM + wc * 32 + 8 * fq;
#pragma unroll
        for (int ai = 0; ai < 2; ++ai)
#pragma unroll
            for (int m = 0; m < 4; ++m) { bf16_t* rowp = O + (size_t)(row0 + ai * HALF + m * 16) * ldc + col0;
#pragma unroll
                for (int bj = 0; bj < 2; ++bj) { const f32x4 v0 = acc[ai][bj][m][0], v1 = acc[ai][bj][m][1];
                    u32x4 w; w.x = cvt_pk_bf16(v0[0], v0[1]); w.y = cvt_pk_bf16(v0[2], v0[3]); w.z = cvt_pk_bf16(v1[0], v1[1]); w.w = cvt_pk_bf16(v1[2], v1[3]);
                    *(u32x4*)(rowp + bj * HALF) = w; } }
    }
};
struct EpiGU {
    static constexpr bool PERM = true, AFTER_DRAIN = false;
    bf16_t* ACT;
    __device__ __forceinline__ void operator()(const f32x4 (&acc)[2][2][4][2], const Unit& u, int wr, int wc, int fr, int fq) const {
        const int row0 = u.pm * BM + wr * 64 + fr, col0 = u.pn * HALF + wc * 32 + 8 * fq;
#pragma unroll
        for (int ai = 0; ai < 2; ++ai)
#pragma unroll
            for (int m = 0; m < 4; ++m) { bf16_t* rowp = ACT + (size_t)(row0 + ai * HALF + m * 16) * 512 + col0; float o[8];
#pragma unroll
                for (int n = 0; n < 2; ++n)
#pragma unroll
                    for (int j = 0; j < 4; ++j) { const float gt = acc[ai][0][m][n][j], up = acc[ai][1][m][n][j]; o[4 * n + j] = gt * __builtin_amdgcn_rcpf(1.f + __expf(-gt)) * up; }
                u32x4 w; w.x = cvt_pk_bf16(o[0], o[1]); w.y = cvt_pk_bf16(o[2], o[3]); w.z = cvt_pk_bf16(o[4], o[5]); w.w = cvt_pk_bf16(o[6], o[7]);
                *(u32x4*)rowp = w; }
    }
};
struct EpiResF32 {
    static constexpr bool PERM = false, AFTER_DRAIN = false;
    const float* xi; float* xo; const float* gate;
    __device__ __forceinline__ void operator()(const f32x4 (&acc)[2][2][4][2], const Unit& u, int wr, int wc, int fr, int fq) const {
        const int row0 = u.pm * BM + wr * 64 + fr, col0 = u.pn * BM + wc * 32 + 4 * fq;
        f32x4 gv[2][2];
#pragma unroll
        for (int bj = 0; bj < 2; ++bj)
#pragma unroll
            for (int n = 0; n < 2; ++n) gv[bj][n] = *(const f32x4*)(gate + col0 + bj * HALF + n * 16);
#pragma unroll
        for (int ai = 0; ai < 2; ++ai)
#pragma unroll
            for (int m = 0; m < 4; ++m) { const size_t off = (size_t)(row0 + ai * HALF + m * 16) * 1024 + col0;
#pragma unroll
                for (int bj = 0; bj < 2; ++bj)
#pragma unroll
                    for (int n = 0; n < 2; ++n) *(f32x4*)(xo + off + bj * HALF + n * 16) = *(const f32x4*)(xi + off + bj * HALF + n * 16) + gv[bj][n] * acc[ai][bj][m][n]; }
    }
};
struct GroupedOrder {
    int nunits, G, c, nN; const int* blk; long wbytes;
    __device__ __forceinline__ bool next(int i, Unit& u) const {
        const long L = (long)i * G + c; if (L >= nunits) return false;
        const int b = (int)(L / nN); u.pm = b; u.pn = (int)(L % nN);
        const int e = __builtin_amdgcn_readfirstlane((int)__hip_atomic_load((const unsigned*)blk + 1 + b, __ATOMIC_RELAXED, __HIP_MEMORY_SCOPE_AGENT));
        u.boff = (long)e * wbytes; return true;
    }
    __device__ __forceinline__ void a_ready(const Unit&) const {}
    __device__ __forceinline__ void done(const Unit&) const {}
};

template <class Epi, class Sched, bool ALIGN_EPI = false, bool SP2 = false>
__device__ __forceinline__ void gemm_phase(PG8_LAS unsigned char* lds, const Gemm g, const Sched& S, const Epi& E, const int tid_in) {
    const int tid = tid_in, wid = __builtin_amdgcn_readfirstlane(tid >> 6), lane = tid & 63, wr = wid >> 2, wc = wid & 3, fr = lane & 15, fq = lane >> 4;
    const int K = g.K, nt = K / BK;
    unsigned voffA[2], voffB[2];
#pragma unroll
    for (int i = 0; i < 2; ++i) { int R, C; stage_rc(tid * 16 + i * 8192, R, C); const int Rb = Epi::PERM ? ((R & ~31) + perm32(R & 31)) : R;
        voffA[i] = (unsigned)(R * K + C) * 2u; voffB[i] = (unsigned)(Rb * K + C) * 2u; }
    const size_t kstep = (size_t)(BK * 2);
    const size_t hstep = (size_t)HALF * K * 2;
    const size_t tstep = 2 * hstep;
    const unsigned ldsw = (unsigned)wid * 1024u;
    const int aoff = lds_byte(wr * 64 + fr, fq * 8), boff = lds_byte(wc * 32 + fr, fq * 8);
#define PG8_SA(b, h) (((b) * 2 + (h)) * HTB)
#define PG8_SB(b, h) ((4 + (b) * 2 + (h)) * HTB)
#define PG8_STAGE(bufoff, gbase, voff) do { _Pragma("unroll") for (int _i = 0; _i < 2; ++_i) \
        __builtin_amdgcn_global_load_lds((const unsigned*)((const char*)(gbase) + (voff)[_i]), (PG8_LAS unsigned*)(lds + (bufoff) + ldsw + _i * 8192), 16, 0, 0); } while (0)
#define PG8_LDA(dst, b, h) do { _Pragma("unroll") for (int m = 0; m < 4; ++m) _Pragma("unroll") for (int k = 0; k < 2; ++k) dst[m][k] = *(const PG8_LAS bf16x8*)(lds + PG8_SA(b, h) + aoff + m * 2048 + k * 1024); } while (0)
#define PG8_LDB(dst, b, h) do { _Pragma("unroll") for (int n = 0; n < 2; ++n) _Pragma("unroll") for (int k = 0; k < 2; ++k) dst[n][k] = *(const PG8_LAS bf16x8*)(lds + PG8_SB(b, h) + boff + n * 2048 + k * 1024); } while (0)
#define PG8_MMA(ai, bj, At, Bt) do { __builtin_amdgcn_s_setprio(1); _Pragma("unroll") for (int m = 0; m < 4; ++m) _Pragma("unroll") for (int n = 0; n < 2; ++n) _Pragma("unroll") for (int k = 0; k < 2; ++k) \
        acc[ai][bj][m][n] = __builtin_amdgcn_mfma_f32_16x16x32_bf16(Bt[n][k], At[m][k], acc[ai][bj][m][n], 0, 0, 0); __builtin_amdgcn_s_setprio(0); } while (0)
#define PG8_WAIT_V(n) asm volatile("s_waitcnt vmcnt(" #n ")" ::: "memory")
#define PG8_WAIT_L(n) asm volatile("s_waitcnt lgkmcnt(" #n ")" ::: "memory")
#define PG8_BAR __builtin_amdgcn_s_barrier()
#define PG8_SCHED __builtin_amdgcn_sched_barrier(0)
    Unit cur, nxt; int ui = 0;
    if (!S.next(0, cur)) return;
    f32x4 acc[2][2][4][2];
#pragma unroll
    for (int a = 0; a < 2; ++a)
#pragma unroll
        for (int b = 0; b < 2; ++b)
#pragma unroll
            for (int m = 0; m < 4; ++m)
#pragma unroll
                for (int n = 0; n < 2; ++n) acc[a][b][m][n] = (f32x4){0.f, 0.f, 0.f, 0.f};
    bf16x8 At[4][2], B0[2][2], B1[2][2];
    const char* cA = (const char*)g.A + (size_t)cur.pm * tstep; const char* cB = (const char*)g.Bt + cur.boff + (size_t)cur.pn * tstep;
    S.a_ready(cur);
    if constexpr (SP2) {
        PG8_STAGE(PG8_SB(0, 0), cB, voffB); PG8_STAGE(PG8_SB(0, 1), cB + hstep, voffB); PG8_STAGE(PG8_SA(0, 0), cA, voffA); PG8_STAGE(PG8_SA(0, 1), cA + hstep, voffA);
        if (wr == 1) PG8_BAR;
        PG8_WAIT_V(2); PG8_BAR;
        PG8_STAGE(PG8_SB(1, 0), cB + kstep, voffB); PG8_STAGE(PG8_SA(1, 0), cA + kstep, voffA); PG8_STAGE(PG8_SB(1, 1), cB + hstep + kstep, voffB);
        PG8_WAIT_V(6); PG8_BAR;
    } else {
        PG8_STAGE(PG8_SB(0, 0), cB, voffB); PG8_STAGE(PG8_SA(0, 0), cA, voffA); PG8_STAGE(PG8_SB(0, 1), cB + hstep, voffB); PG8_STAGE(PG8_SA(0, 1), cA + hstep, voffA);
        if (wr == 1) PG8_BAR;
        PG8_WAIT_V(4); PG8_BAR;
        PG8_STAGE(PG8_SB(1, 0), cB + kstep, voffB); PG8_STAGE(PG8_SA(1, 0), cA + kstep, voffA); PG8_STAGE(PG8_SB(1, 1), cB + hstep + kstep, voffB);
        PG8_WAIT_V(6); PG8_BAR;
    }
    for (;;) {
        const bool has_next = S.next(ui + 1, nxt);
        const char* nA = has_next ? (const char*)g.A + (size_t)nxt.pm * tstep : cA; const char* nB = has_next ? (const char*)g.Bt + nxt.boff + (size_t)nxt.pn * tstep : cB;
        for (int t = 0; t < nt; t += 2) {
            const bool last = (t == nt - 2);
            const char* a1 = cA + (size_t)(t + 1) * kstep;
            const char* a2 = last ? nA : cA + (size_t)(t + 2) * kstep; const char* b2 = last ? nB : cB + (size_t)(t + 2) * kstep;
            const char* a3 = a2 + kstep; const char* b3 = b2 + kstep;
            if (last && has_next) S.a_ready(nxt);
            if constexpr (SP2) {
            PG8_LDB(B0, 0, 0); PG8_LDB(B1, 0, 1); PG8_SCHED; PG8_LDA(At, 0, 0); PG8_STAGE(PG8_SA(1, 1), a1 + hstep, voffA);
            PG8_WAIT_V(8); PG8_WAIT_L(0); PG8_BAR; PG8_MMA(0, 0, At, B0); PG8_MMA(0, 1, At, B1); PG8_BAR; PG8_SCHED;
            PG8_LDA(At, 0, 1); PG8_STAGE(PG8_SB(0, 0), b2, voffB); PG8_STAGE(PG8_SB(0, 1), b2 + hstep, voffB); PG8_STAGE(PG8_SA(0, 0), a2, voffA);
            PG8_WAIT_V(8); PG8_WAIT_L(0); PG8_BAR; PG8_MMA(1, 0, At, B0); PG8_MMA(1, 1, At, B1); PG8_BAR; PG8_SCHED;
            PG8_LDB(B0, 1, 0); PG8_LDB(B1, 1, 1); PG8_SCHED; PG8_LDA(At, 1, 0); PG8_STAGE(PG8_SA(0, 1), a2 + hstep, voffA);
            PG8_WAIT_V(8); PG8_WAIT_L(0); PG8_BAR; PG8_MMA(0, 0, At, B0); PG8_MMA(0, 1, At, B1); PG8_BAR; PG8_SCHED;
            PG8_LDA(At, 1, 1); PG8_STAGE(PG8_SB(1, 0), b3, voffB); PG8_STAGE(PG8_SB(1, 1), b3 + hstep, voffB); PG8_STAGE(PG8_SA(1, 0), a3, voffA);
            PG8_WAIT_V(8); PG8_WAIT_L(0); PG8_BAR; PG8_MMA(1, 0, At, B0); PG8_MMA(1, 1, At, B1); PG8_BAR; PG8_SCHED;
            } else {
            PG8_LDB(B0, 0, 0); PG8_SCHED; PG8_LDA(At, 0, 0); PG8_STAGE(PG8_SA(1, 1), a1 + hstep, voffA);
            PG8_WAIT_L(8); PG8_BAR; PG8_WAIT_L(0); PG8_MMA(0, 0, At, B0); PG8_BAR; PG8_SCHED;
            PG8_LDB(B1, 0, 1); PG8_STAGE(PG8_SB(0, 0), b2, voffB);
            PG8_BAR; PG8_WAIT_L(0); PG8_MMA(0, 1, At, B1); PG8_BAR;
            PG8_LDA(At, 0, 1); PG8_STAGE(PG8_SA(0, 0), a2, voffA);
            PG8_BAR; PG8_WAIT_L(0); PG8_MMA(1, 0, At, B0); PG8_BAR; PG8_SCHED;
            PG8_STAGE(PG8_SB(0, 1), b2 + hstep, voffB);
            PG8_WAIT_V(6); PG8_BAR; PG8_MMA(1, 1, At, B1); PG8_BAR;
            PG8_LDB(B0, 1, 0); PG8_SCHED; PG8_LDA(At, 1, 0); PG8_STAGE(PG8_SA(0, 1), a2 + hstep, voffA);
            PG8_WAIT_L(8); PG8_BAR; PG8_WAIT_L(0); PG8_MMA(0, 0, At, B0); PG8_BAR; PG8_SCHED;
            PG8_LDB(B1, 1, 1); PG8_STAGE(PG8_SB(1, 0), b3, voffB);
            PG8_BAR; PG8_WAIT_L(0); PG8_MMA(0, 1, At, B1); PG8_BAR;
            PG8_LDA(At, 1, 1); PG8_STAGE(PG8_SA(1, 0), a3, voffA);
            PG8_BAR; PG8_WAIT_L(0); PG8_MMA(1, 0, At, B0); PG8_BAR; PG8_SCHED;
            PG8_STAGE(PG8_SB(1, 1), b3 + hstep, voffB);
            PG8_WAIT_V(6); PG8_BAR; PG8_MMA(1, 1, At, B1); PG8_BAR;
            }
        }
        if constexpr (ALIGN_EPI) { if (wr == 0) PG8_BAR; }
        if constexpr (!Epi::AFTER_DRAIN) { E(acc, cur, wr, wc, fr, fq); S.done(cur); }
        if (!has_next) break;
#pragma unroll
        for (int a = 0; a < 2; ++a)
#pragma unroll
            for (int b = 0; b < 2; ++b)
#pragma unroll
                for (int m = 0; m < 4; ++m)
#pragma unroll
                    for (int n = 0; n < 2; ++n) acc[a][b][m][n] = (f32x4){0.f, 0.f, 0.f, 0.f};
        cur = nxt; cA = nA; cB = nB; ++ui;
        if constexpr (ALIGN_EPI) { if (wr == 1) PG8_BAR; }
    }
    PG8_WAIT_V(0);
    if constexpr (!ALIGN_EPI) { if (wr == 0) PG8_BAR; }
    PG8_BAR;
    if constexpr (Epi::AFTER_DRAIN) { E.fused(acc, cur, wr, wc, fr, fq, lds, wid, lane); S.done(cur); }
#undef PG8_SA
#undef PG8_SB
#undef PG8_STAGE
#undef PG8_LDA
#undef PG8_LDB
#undef PG8_MMA
#undef PG8_WAIT_V
#undef PG8_WAIT_L
#undef PG8_BAR
#undef PG8_SCHED
}

}

DEV void load64(const bf16_t* p, float* x) {
#pragma unroll
    for (int c = 0; c < 8; ++c) unpack8(((const bf16x8*)p)[c], x + 8 * c);
}
DEV void store64(bf16_t* p, const float* x) {
#pragma unroll
    for (int c = 0; c < 8; ++c) ((u32x4*)p)[c] = pack8(x + 8 * c);
}
DEV float sum8lanes(float v) { v += __shfl_xor(v, 1); v += __shfl_xor(v, 2); v += __shfl_xor(v, 4); return v; }
DEV void phase_pre_even(KArgsP a, const Fr& F, int i) {
    bf16_t* P = (bf16_t*)(a->ws + WS_P); const f32x2* tab = (const f32x2*)(a->ws + WS_ROPE);
    const int total = NTOK * 26 * 8;
    for (int it = F.bid * NTHR + F.tid; it < total; it += F.G * NTHR) {
        const int j8 = it & 7, gidx = it >> 3, row = gidx / 26, gi = gidx % 26, grp = gi < 10 ? gi : gi + 2;
        bf16_t* p = P + (size_t)row * EV_IN + grp * 64 + 8 * j8; float x[8]; unpack8(*(const bf16x8*)p, x);
        if (grp >= 12) {
#pragma unroll
            for (int d = 0; d < 8; ++d) x[d] = gelu_tanh(x[d]);
        }
        float ss = 0.f;
#pragma unroll
        for (int d = 0; d < 8; ++d) ss += x[d] * x[d];
        ss = sum8lanes(ss);
        const float r = rsqrtf(ss * (1.f / 64.f) + EPS) * (grp < 8 ? ATT_C2 : 1.f);
        if (grp < 10 || grp >= 20) {
            const float* gn = grp < 8 ? a->in[I_AQN] + i * 64 : (grp < 10 ? a->in[I_AKN] + i * 64 : a->in[I_BVN] + i * 512 + (grp - 20) * 64);
#pragma unroll
            for (int d = 0; d < 8; ++d) x[d] *= r * gn[8 * j8 + d];
        }
        float y[8];
#pragma unroll
        for (int d = 0; d < 8; ++d) y[d] = __shfl_xor(x[d], 2);
        if (grp < 10 && row < SEQ) {
            const int pos = (j8 & 4) ? (row % GRIDW) : (row / GRIDW); const bool second = (j8 & 2) != 0;
#pragma unroll
            for (int d = 0; d < 8; ++d) { const f32x2 cs = tab[pos * 16 + 8 * (j8 & 1) + d]; x[d] = second ? (x[d] * cs.x + y[d] * cs.y) : (x[d] * cs.x - y[d] * cs.y); }
        }
        *(u32x4*)p = pack8(x);
    }
}
DEV void phase_pre_odd(KArgsP a, const Fr& F, int i) {
    bf16_t* P = (bf16_t*)(a->ws + WS_P);
    const int total = NTOK * 24 * 8;
    for (int it = F.bid * NTHR + F.tid; it < total; it += F.G * NTHR) {
        const int j8 = it & 7, gidx = it >> 3, row = gidx / 24, gi = gidx % 24;
        bf16_t* p = P + (size_t)row * OD_IN + (gi < 16 ? gi * 64 : 1536 + (gi - 16) * 64) + 8 * j8; float x[8]; unpack8(*(const bf16x8*)p, x);
        float ss = 0.f;
#pragma unroll
        for (int d = 0; d < 8; ++d) ss += x[d] * x[d];
        ss = sum8lanes(ss);
        if (gi < 16) {
            const float r = rsqrtf(ss * (1.f / 64.f) + EPS) * (gi < 8 ? ATT_C2 : 1.f); const float* gn = a->in[gi < 8 ? I_CQN : I_CKN] + i * 64;
#pragma unroll
            for (int d = 0; d < 8; ++d) x[d] *= r * gn[8 * j8 + d];
        } else {
            float xg[8]; unpack8(*(const bf16x8*)(p + 512), xg);
#pragma unroll
            for (int d = 0; d < 8; ++d) x[d] *= sigmoidf_(xg[d]);
        }
        *(u32x4*)p = pack8(x);
    }
}

namespace attn_body {
using bf16=__hip_bfloat16;
using bf16x8=__attribute__((ext_vector_type(8)))short;
using s16x4=__attribute__((ext_vector_type(4)))short;
using f32x16=__attribute__((ext_vector_type(16)))float;
using u32x4=__attribute__((ext_vector_type(4)))unsigned;
constexpr int D=64;
constexpr int NW=8,QBLK=32,QB=QBLK*NW,KVBLK=64;
constexpr int ATTN_UNIT_ROWS=QB;
__device__ __forceinline__ int crow(int r,int hi){return (r&3)+8*(r>>2)+4*hi;}
#define SBAR() __builtin_amdgcn_sched_barrier(0)
__device__ __forceinline__ void cmask(f32x16&p0,f32x16&p1,int jb,int qrel,int hi){
  const float NEG=-INFINITY; int kb=64*jb+4*hi;
  #pragma unroll
  for(int r=0;r<16;++r){int kv=kb+(r&3)+8*(r>>2); if(kv>qrel)p0[r]=NEG; if(kv+32>qrel)p1[r]=NEG;}
}

constexpr int NSLOT=3, SLOTB=8192;
constexpr int LDS_K=0, LDS_V=NSLOT*SLOTB, LDS_WS=2*NSLOT*SLOTB, LDS_OST=LDS_WS+NW*64*4, LDS_BYTES=LDS_OST+NW*4096;
constexpr float C2=0.125f*1.4426950408889634f;
__device__ __forceinline__ void glds16(const void*gsrc,unsigned lds_dst){unsigned keep;
  asm volatile("s_mov_b32 %0, m0\n\ts_mov_b32 m0, %2\n\ts_nop 0\n\tglobal_load_lds_dwordx4 %1, off\n\ts_mov_b32 m0, %0":"=&s"(keep):"v"(gsrc),"s"(lds_dst):"memory");}
__device__ __forceinline__ float max3f(float a,float b,float c){float r;asm("v_max3_f32 %0, %1, %2, %3":"=v"(r):"v"(a),"v"(b),"v"(c));return r;}
__device__ __forceinline__ float max2f(float a,float b){float r;asm("v_max_f32_e32 %0, %1, %2":"=v"(r):"v"(a),"v"(b));return r;}
__device__ __forceinline__ float fadd_s(float a,float b){float r;asm("v_add_f32_e32 %0, %1, %2":"=v"(r):"v"(a),"v"(b));return r;}
__device__ __forceinline__ float fsub_s(float a,float b){float r;asm("v_sub_f32_e32 %0, %1, %2":"=v"(r):"v"(a),"v"(b));return r;}
typedef float f32x2_t __attribute__((ext_vector_type(2))); typedef __bf16 bf16x2_t __attribute__((ext_vector_type(2)));
__device__ __forceinline__ unsigned cvtpk_s(float lo,float hi){f32x2_t v={lo,hi};bf16x2_t b=__builtin_convertvector(v,bf16x2_t);return __builtin_bit_cast(unsigned,b);}
#define WAIT_BAR(N) asm volatile("s_waitcnt vmcnt(" #N ") lgkmcnt(0)\n\ts_barrier":::"memory")

__device__ __forceinline__ void qkt(f32x16&p0,f32x16&p1,const char*Kslot,const bf16x8*qr,const f32x16&negm,int r32,int hi){
  const char*kb=Kslot+hi*1024+r32*16;
  #pragma unroll
  for(int d0=0;d0<4;++d0){
    const bf16x8 b0=*reinterpret_cast<const bf16x8*>(kb+d0*2048);
    const bf16x8 b1=*reinterpret_cast<const bf16x8*>(kb+d0*2048+512);
    if(d0==0){p0=__builtin_amdgcn_mfma_f32_32x32x16_bf16(b0,qr[0],negm,0,0,0);p1=__builtin_amdgcn_mfma_f32_32x32x16_bf16(b1,qr[0],negm,0,0,0);}
    else{p0=__builtin_amdgcn_mfma_f32_32x32x16_bf16(b0,qr[d0],p0,0,0,0);p1=__builtin_amdgcn_mfma_f32_32x32x16_bf16(b1,qr[d0],p1,0,0,0);}}
}
typedef __attribute__((address_space(3))) const char* lds_cptr;
typedef short v4i16_t __attribute__((ext_vector_type(4)));
__device__ __forceinline__ void kload8(bf16x8*kf,lds_cptr kp){
  kf[0]=*(const __attribute__((address_space(3))) bf16x8*)(kp);      kf[1]=*(const __attribute__((address_space(3))) bf16x8*)(kp+512);
  kf[2]=*(const __attribute__((address_space(3))) bf16x8*)(kp+2048); kf[3]=*(const __attribute__((address_space(3))) bf16x8*)(kp+2560);
  kf[4]=*(const __attribute__((address_space(3))) bf16x8*)(kp+4096); kf[5]=*(const __attribute__((address_space(3))) bf16x8*)(kp+4608);
  kf[6]=*(const __attribute__((address_space(3))) bf16x8*)(kp+6144); kf[7]=*(const __attribute__((address_space(3))) bf16x8*)(kp+6656);
}
__device__ __forceinline__ void kload2(bf16x8*kf,lds_cptr kp,int j){ kf[2*j]=*(const __attribute__((address_space(3))) bf16x8*)(kp+j*2048); kf[2*j+1]=*(const __attribute__((address_space(3))) bf16x8*)(kp+j*2048+512); }
__device__ __forceinline__ s16x4 vtr(lds_cptr p){ return __builtin_bit_cast(s16x4,__builtin_amdgcn_ds_read_tr16_b64_v4i16((__attribute__((address_space(3))) v4i16_t*)p)); }
__device__ __forceinline__ float rowmax(const f32x16&p0,const f32x16&p1){
  float a=max3f(p0[0],p0[1],p1[0]),b=max3f(p0[2],p0[3],p1[1]);a=max3f(a,p1[2],p1[3]);
  #pragma unroll
  for(int r=4;r<16;r+=4){a=max3f(a,p0[r],p0[r+1]);b=max3f(b,p0[r+2],p0[r+3]);a=max3f(a,p1[r],p1[r+1]);b=max3f(b,p1[r+2],p1[r+3]);}
  const float m=max2f(a,b);
  auto rr=__builtin_amdgcn_permlane32_swap(__float_as_uint(m),__float_as_uint(m),false,false);
  return max2f(__uint_as_float(rr[0]),__uint_as_float(rr[1]));
}
__device__ __forceinline__ void pv(f32x16*o,int vb,bf16x8 pa0,bf16x8 pa1,bf16x8 pa2,bf16x8 pa3){
  #pragma unroll
  for(int d0=0;d0<2;++d0){s16x4 lo[4],hi[4];
    #pragma unroll
    for(int ks=0;ks<4;++ks){
      asm volatile("ds_read_b64_tr_b16 %0,%1 offset:%c2":"=&v"(lo[ks]):"v"(vb),"i"(d0*4096+ks*1024):"memory");
      asm volatile("ds_read_b64_tr_b16 %0,%1 offset:%c2":"=&v"(hi[ks]):"v"(vb),"i"(d0*4096+ks*1024+512):"memory");}
    asm volatile("s_waitcnt lgkmcnt(0)":::"memory");SBAR();
    #define PK(k) (bf16x8){lo[k][0],lo[k][1],lo[k][2],lo[k][3],hi[k][0],hi[k][1],hi[k][2],hi[k][3]}
    o[d0]=__builtin_amdgcn_mfma_f32_32x32x16_bf16(pa0,PK(0),o[d0],0,0,0);
    o[d0]=__builtin_amdgcn_mfma_f32_32x32x16_bf16(pa1,PK(1),o[d0],0,0,0);
    o[d0]=__builtin_amdgcn_mfma_f32_32x32x16_bf16(pa2,PK(2),o[d0],0,0,0);
    o[d0]=__builtin_amdgcn_mfma_f32_32x32x16_bf16(pa3,PK(3),o[d0],0,0,0);
    #undef PK
  }
}

#ifndef ATTN_STORE16
#define ATTN_STORE16(p,v) (*(u32x4*)(p)=(v))
#endif
template<int THRL,bool NEGM,class TM> __device__ __forceinline__ void attn_unit(const bf16*Qu,const int qp,const bf16*Kh,const bf16*Vh,const int kvp,bf16*Ou,const int op,const int NT,const TM&tm,const int tid,char*shm){
  const int lane=tid&63,r32=lane&31,hi=lane>>5; const int wid=__builtin_amdgcn_readfirstlane(tid>>6);
  const bf16*Qw=Qu+(long)(wid*QBLK)*qp;
  const unsigned lds0=(unsigned)(uintptr_t)shm;
  float*wsf=(float*)(shm+LDS_WS)+wid*64;
  const bf16*ksrc=Kh+(long)lane*kvp+wid*8;
  const bf16*vsrc=Vh+(long)(16*(wid&3)+(lane>>2))*kvp+(wid>>2)*32+(lane&3)*8;
  const unsigned kdst=lds0+LDS_K+wid*1024, vdst=lds0+LDS_V+wid*1024;
  #define DMA_K(t,slot) glds16(ksrc+(long)tm.row(t)*kvp,(unsigned)__builtin_amdgcn_readfirstlane(kdst+(slot)))
  #define DMA_V(t,slot) glds16(vsrc+(long)tm.row(t)*kvp,(unsigned)__builtin_amdgcn_readfirstlane(vdst+(slot)))
  const int vb0=(int)(lds0+LDS_V)+((lane>>4)&1)*32+(lane&3)*8+(4*hi+((lane&15)>>2))*64;
  const char*Kbase=shm+LDS_K; bf16x8 kf[8];
  const lds_cptr shm3=(lds_cptr)shm; const lds_cptr kp0=shm3+LDS_K+hi*1024+r32*16; const lds_cptr vp0=shm3+LDS_V+((lane>>4)&1)*32+(lane&3)*8+(4*hi+((lane&15)>>2))*64;
  DMA_K(0,0);DMA_V(0,0);DMA_K(1,SLOTB);
  bf16x8 qr[4];
  #pragma unroll
  for(int d0=0;d0<4;++d0)qr[d0]=*reinterpret_cast<const bf16x8*>(&Qw[(long)r32*qp+d0*16+hi*8]);
  float mhat=0.f,l_reg=0.f;f32x16 o[2];o[0]=f32x16{};o[1]=f32x16{};f32x16 negm=f32x16{};if(NEGM)asm volatile("":"+v"(negm));
  #define CMASK(P0,P1,t) tm.mask(P0,P1,(t),wid,r32,hi)
  bool resc=false;
  #define START(P0,P1) do{ const float rm=rowmax(P0,P1); resc=false; \
    { const float dl=rm; mhat=fadd_s(mhat,dl); \
      _Pragma("unroll") for(int r=0;r<16;++r){P0[r]=fsub_s(P0[r],dl);P1[r]=fsub_s(P1[r],dl);} \
      if(NEGM){ _Pragma("unroll") for(int r=0;r<16;++r)negm[r]=-mhat; asm volatile("":"+v"(negm)); } } \
    _Pragma("unroll") for(int r=0;r<16;++r)P0[r]=__builtin_amdgcn_exp2f(P0[r]); }while(0)
  #define RESC() do{ if(resc){ asm volatile("s_waitcnt lgkmcnt(0)":::"memory"); \
      _Pragma("unroll") for(int d_=0;d_<2;++d_) _Pragma("unroll") for(int r=0;r<16;++r)o[d_][r]*=wsf[crow(r,hi)]; } }while(0)
  f32x16 pA0,pA1,pB0,pB1;
  int sl_prev=0,sl_cur=0,sl_next=SLOTB;
  #define ROT() do{sl_prev=sl_cur;sl_cur=sl_next;sl_next=(sl_next==(NSLOT-1)*SLOTB)?0:sl_next+SLOTB;}while(0)
  DMA_K(2,2*SLOTB);
  WAIT_BAR(3);
  qkt(pA0,pA1,Kbase,qr,negm,r32,hi);asm volatile("s_nop 15\n\ts_nop 7":"+v"(pA0),"+v"(pA1));CMASK(pA0,pA1,0);
  START(pA0,pA1);
  _Pragma("unroll") for(int r=0;r<16;++r)pA1[r]=__builtin_amdgcn_exp2f(pA1[r]);
  WAIT_BAR(0);
  DMA_K(3,0);DMA_V(1,SLOTB);
  ROT();
  kload8(kf,kp0+sl_cur);
  WAIT_BAR(2);
  s16x4 vlo[8],vhi[8]; u32x4 pw0,pw1,pw2,pw3;
  #define PKW(P,B) cvtpk_s(P[B],P[B+1])
  #define PAF(k) __builtin_bit_cast(bf16x8,pw##k)
  #define VFR(i) (bf16x8){vlo[i][0],vlo[i][1],vlo[i][2],vlo[i][3],vhi[i][0],vhi[i][1],vhi[i][2],vhi[i][3]}
  #define PIN(x) asm volatile("":"+v"(x))
  #define MX3(a,b,c) __builtin_fmaxf(__builtin_fmaxf((a),(b)),(c))
  #define GAPA(MF,A0,A1,A2,A3,W0,W1,PW) do{ MF; sacc+=A0; sacc+=A1; sacc+=A2; sacc+=A3; PIN(sacc); W0; W1; PIN(PW); SBAR(); }while(0)
  #define EX(v) __builtin_amdgcn_exp2f(v)
  #define GAPB(MF,X,B) do{ MF; X[B]=EX(X[B]); X[B+1]=EX(X[B+1]); X[B+2]=EX(X[B+2]); X[B+3]=EX(X[B+3]); PIN(X); SBAR(); }while(0)
  #define VRD(i) do{ vlo[i]=vtr(vp_+(((i)>>2)*4096+((i)&3)*1024)); vhi[i]=vtr(vp_+(((i)>>2)*4096+((i)&3)*1024+512)); }while(0)
  #define KRD(G,j) do{ if(G){ kload2(kf,kp0+sl_next,j); SBAR(); } }while(0)
  #define STEP(C0,C1,P0,P1,t,GK,GV,GL) do{ SBAR(); \
    const lds_cptr vp_=vp0+sl_prev; \
    VRD(0); SBAR(); float sacc=(P0[0]+P0[1]); \
    GAPA(C0=__builtin_amdgcn_mfma_f32_32x32x16_bf16(kf[0],qr[0],negm,0,0,0), P0[2],P0[3],P0[4],P0[5],     pw0[0]=PKW(P0,0), pw0[1]=PKW(P0,2), pw0); \
    VRD(4); SBAR(); GAPA(C1=__builtin_amdgcn_mfma_f32_32x32x16_bf16(kf[1],qr[0],negm,0,0,0), P0[6],P0[7],P0[8],P0[9],     pw0[2]=PKW(P0,4), pw0[3]=PKW(P0,6), pw0); \
    VRD(1); SBAR(); GAPA(C0=__builtin_amdgcn_mfma_f32_32x32x16_bf16(kf[2],qr[1],C0,0,0,0),   P0[10],P0[11],P0[12],P0[13], pw1[0]=PKW(P0,8), pw1[1]=PKW(P0,10), pw1); \
    VRD(5); SBAR(); GAPA(C1=__builtin_amdgcn_mfma_f32_32x32x16_bf16(kf[3],qr[1],C1,0,0,0),   P0[14],P0[15],P1[0],P1[1],   pw1[2]=PKW(P0,12),pw1[3]=PKW(P0,14), pw1); \
    VRD(2); SBAR(); GAPA(C0=__builtin_amdgcn_mfma_f32_32x32x16_bf16(kf[4],qr[2],C0,0,0,0),   P1[2],P1[3],P1[4],P1[5],     pw2[0]=PKW(P1,0), pw2[1]=PKW(P1,2), pw2); \
    VRD(6); SBAR(); GAPA(C1=__builtin_amdgcn_mfma_f32_32x32x16_bf16(kf[5],qr[2],C1,0,0,0),   P1[6],P1[7],P1[8],P1[9],     pw2[2]=PKW(P1,4), pw2[3]=PKW(P1,6), pw2); \
    VRD(3); SBAR(); GAPA(C0=__builtin_amdgcn_mfma_f32_32x32x16_bf16(kf[6],qr[3],C0,0,0,0),   P1[10],P1[11],P1[12],P1[13], pw3[0]=PKW(P1,8), pw3[1]=PKW(P1,10), pw3); \
    VRD(7); SBAR(); GAPA(C1=__builtin_amdgcn_mfma_f32_32x32x16_bf16(kf[7],qr[3],C1,0,0,0),   P1[14],P1[15],0.f,0.f,       pw3[2]=PKW(P1,12),pw3[3]=PKW(P1,14), pw3); \
    l_reg+=sacc; \
    if(GK){DMA_K((t)+3,sl_cur);} if(GV){DMA_V((t)+1,sl_next);} \
    if(!NEGM){ _Pragma("unroll") for(int r=0;r<16;++r){C0[r]-=mhat;C1[r]-=mhat;} } \
    CMASK(C0,C1,t); \
    { float a=MX3(C0[0],C0[1],C1[0]),b=MX3(C0[2],C0[3],C1[1]); a=MX3(a,C1[2],C1[3]); \
      _Pragma("unroll") for(int r=4;r<16;r+=4){a=MX3(a,C0[r],C0[r+1]);b=MX3(b,C0[r+2],C0[r+3]);a=MX3(a,C1[r],C1[r+1]);b=MX3(b,C1[r+2],C1[r+3]);} \
      float rm=__builtin_fmaxf(a,b); { auto rr=__builtin_amdgcn_permlane32_swap(__float_as_uint(rm),__float_as_uint(rm),false,false); rm=__builtin_fmaxf(__uint_as_float(rr[0]),__uint_as_float(rr[1])); } \
      resc=false; \
      if(__builtin_expect(__any(rm>(float)THRL),0)){ const float dl=__builtin_fmaxf(rm,0.f); mhat+=dl; \
        _Pragma("unroll") for(int r=0;r<16;++r){C0[r]-=dl;C1[r]-=dl;} \
        if(NEGM){ _Pragma("unroll") for(int r=0;r<16;++r)negm[r]=-mhat; asm volatile("":"+v"(negm)); } \
        const float f=__builtin_amdgcn_exp2f(-dl); l_reg*=f; if(hi==0)wsf[r32]=f; resc=true; } } \
    SBAR(); \
    GAPB(o[0]=__builtin_amdgcn_mfma_f32_32x32x16_bf16(PAF(0),VFR(0),o[0],0,0,0), C0,0); \
    GAPB(o[1]=__builtin_amdgcn_mfma_f32_32x32x16_bf16(PAF(0),VFR(4),o[1],0,0,0), C0,4); \
    KRD(GL,0); GAPB(o[0]=__builtin_amdgcn_mfma_f32_32x32x16_bf16(PAF(1),VFR(1),o[0],0,0,0), C0,8); \
    KRD(GL,1); GAPB(o[1]=__builtin_amdgcn_mfma_f32_32x32x16_bf16(PAF(1),VFR(5),o[1],0,0,0), C0,12); \
    KRD(GL,2); GAPB(o[0]=__builtin_amdgcn_mfma_f32_32x32x16_bf16(PAF(2),VFR(2),o[0],0,0,0), C1,0); \
    KRD(GL,3); GAPB(o[1]=__builtin_amdgcn_mfma_f32_32x32x16_bf16(PAF(2),VFR(6),o[1],0,0,0), C1,4); \
    GAPB(o[0]=__builtin_amdgcn_mfma_f32_32x32x16_bf16(PAF(3),VFR(3),o[0],0,0,0), C1,8); \
    GAPB(o[1]=__builtin_amdgcn_mfma_f32_32x32x16_bf16(PAF(3),VFR(7),o[1],0,0,0), C1,12); \
    }while(0)
  int t=1;
  for(;t+5<NT;t+=2){
    STEP(pB0,pB1,pA0,pA1,t,true,true,true);     WAIT_BAR(2); RESC(); ROT();
    STEP(pA0,pA1,pB0,pB1,t+1,true,true,true);   WAIT_BAR(2); RESC(); ROT();
  }
  #define ENDW(tt) do{ if((tt)+3<NT){WAIT_BAR(2);} else if((tt)+2<NT){WAIT_BAR(1);} else {WAIT_BAR(0);} }while(0)
  for(;t+1<NT;t+=2){
    STEP(pB0,pB1,pA0,pA1,t,(t+3<NT),(t+1<NT),(t+1<NT));       ENDW(t);   RESC(); ROT();
    STEP(pA0,pA1,pB0,pB1,t+1,(t+4<NT),(t+2<NT),(t+2<NT));     ENDW(t+1); RESC(); ROT();
  }
  STEP(pB0,pB1,pA0,pA1,NT-1,false,false,false); RESC();
  { float sacc=pB0[0]+pB0[1]; _Pragma("unroll") for(int r=2;r<16;++r)sacc+=pB0[r]; _Pragma("unroll") for(int r=0;r<16;++r)sacc+=pB1[r]; l_reg+=sacc;
    pw0=(u32x4){PKW(pB0,0),PKW(pB0,2),PKW(pB0,4),PKW(pB0,6)};pw1=(u32x4){PKW(pB0,8),PKW(pB0,10),PKW(pB0,12),PKW(pB0,14)};pw2=(u32x4){PKW(pB1,0),PKW(pB1,2),PKW(pB1,4),PKW(pB1,6)};pw3=(u32x4){PKW(pB1,8),PKW(pB1,10),PKW(pB1,12),PKW(pB1,14)};
    SBAR(); pv(o,vb0+sl_cur,PAF(0),PAF(1),PAF(2),PAF(3)); }
  #undef PKW
  #undef PAF
  #undef VFR
  #undef PIN
  #undef MX3
  #undef GAPA
  #undef GAPB
  #undef EX
  #undef VRD
  #undef KRD
  #undef STEP
  #undef ENDW
  {auto rr=__builtin_amdgcn_permlane32_swap(__float_as_uint(l_reg),__float_as_uint(l_reg),false,false);l_reg=__uint_as_float(rr[0])+__uint_as_float(rr[1]);}
  if(hi==0)wsf[32+r32]=l_reg;asm volatile("s_waitcnt lgkmcnt(0)":::"memory");
  float rli[16];
  #pragma unroll
  for(int r=0;r<16;++r)rli[r]=__builtin_amdgcn_rcpf(wsf[32+crow(r,hi)]);
  bf16*Ow=Ou+(long)(wid*QBLK)*op;
  { bf16*stg=(bf16*)(shm+LDS_OST)+wid*2048;
    #pragma unroll
    for(int r=0;r<16;++r){const int orow=crow(r,hi);
      #pragma unroll
      for(int d0=0;d0<2;++d0)stg[orow*64+d0*32+r32]=__float2bfloat16(o[d0][r]*rli[r]);}
    asm volatile("s_waitcnt lgkmcnt(0)":::"memory");
    #pragma unroll
    for(int i=0;i<4;++i){const int row=i*8+(lane>>3),ch=lane&7; const u32x4 v=*(const u32x4*)(stg+row*64+ch*8); ATTN_STORE16(Ow+(long)row*op+ch*8,v);} }
  asm volatile("s_waitcnt lgkmcnt(0)\n\ts_barrier":::"memory");
  #undef DMA_K
  #undef DMA_V
  #undef CMASK
  #undef START
  #undef RESC
  #undef ROT
}
constexpr int ATTN_LDS_BYTES=LDS_BYTES;
#undef SBAR
#undef WAIT_BAR
}

struct OnlineSm { float q[64], o[64], m, l; };
DEV void osm_init(OnlineSm& S, const bf16_t* qp, float scale) {
    load64(qp, S.q);
#pragma unroll
    for (int d = 0; d < 64; ++d) { S.q[d] *= scale; S.o[d] = 0.f; }
    S.m = -1e30f; S.l = 0.f;
}
DEV void osm_key(OnlineSm& S, const bf16_t* kp, const bf16_t* vp, float bias) {
    float s = bias;
#pragma unroll
    for (int c = 0; c < 8; ++c) { float kf[8]; unpack8(((const bf16x8*)kp)[c], kf);
#pragma unroll
        for (int j = 0; j < 8; ++j) s += S.q[8 * c + j] * kf[j]; }
    if (s > S.m) { const float sc = __expf(S.m - s); S.l *= sc;
#pragma unroll
        for (int d = 0; d < 64; ++d) S.o[d] *= sc;
        S.m = s; }
    const float p = __expf(s - S.m); S.l += p;
#pragma unroll
    for (int c = 0; c < 8; ++c) { float vf[8]; unpack8(((const bf16x8*)vp)[c], vf);
#pragma unroll
        for (int j = 0; j < 8; ++j) S.o[8 * c + j] += p * vf[j]; }
}
DEV void osm_store(OnlineSm& S, bf16_t* op) {
    const float rl = 1.f / S.l;
#pragma unroll
    for (int d = 0; d < 64; ++d) S.o[d] *= rl;
    store64(op, S.o);
}

struct TMDense {
    DEV int row(int t) const { return t < 4 ? SEQ + 64 * t : 64 * (t - 4); }
    DEV void mask(attn_body::f32x16&, attn_body::f32x16&, int, int, int, int) const {}
};
DEV void phase_mix_even(KArgsP a, const Fr& F, int i) {
    const bf16_t* P = (const bf16_t*)(a->ws + WS_P); bf16_t* MX = (bf16_t*)(a->ws + WS_MX);
    { typedef attn_body::bf16 abf; const int vcu = (F.G % 8 == 0) ? (F.bid % 8) * (F.G / 8) + F.bid / 8 : F.bid;
      for (int k = 0;; ++k) {
          int u; if (F.G == 256) u = k < 2 ? 2 * vcu + k : ((k == 2 && vcu < 8) ? 512 + vcu : -1); else u = (k * F.G + vcu < 520) ? k * F.G + vcu : -1;
          if (u < 0) break;
          int h, row0, NT; if (u < 512) { h = (u >> 8) * 4 + ((u & 255) >> 6); row0 = (u & 63) * 256; NT = NTOK / 64; } else { h = u - 512; row0 = SEQ; NT = NCTX / 64; }
          const int kvh = h >> 2;
          attn_body::attn_unit<8, true>((const abf*)P + (size_t)row0 * EV_IN + h * 64, EV_IN, (const abf*)P + 512 + kvh * 64, (const abf*)P + 640 + kvh * 64, EV_IN,
                                  (abf*)MX + (size_t)row0 * DM + h * 64, DM, NT, TMDense{}, F.tid, (char*)F.lds);
      } }
}
DEV void phase_mix_even_b(KArgsP a, const Fr& F, int i) {
    const bf16_t* P = (const bf16_t*)(a->ws + WS_P); bf16_t* MX = (bf16_t*)(a->ws + WS_MX);
    LAS float* vn = (LAS float*)F.lds;
    LAS float* wsl = vn + 128 * 64;
    const float* BW = a->in[I_BWS] + (size_t)i * 8 * 128 * 128; const float* BB = a->in[I_BBS] + i * 8 * 128;
    for (int it = F.bid; it < (NTOK / 128) * 8; it += F.G) {
        const int n = it >> 3, g = it & 7;
        __syncthreads();
        for (int e = F.tid; e < 128 * 64; e += NTHR) { const int s = e >> 6, c = e & 63; vn[e] = bf2f(P[(size_t)(n * 128 + s) * EV_IN + 1280 + g * 64 + c]); }
        for (int e = F.tid; e < 128 * 128; e += NTHR) wsl[e] = BW[(size_t)g * 128 * 128 + e];
        __syncthreads();
        const int c = F.tid & 63, t0 = (F.tid >> 6) * 16; float acc[16];
#pragma unroll
        for (int q = 0; q < 16; ++q) acc[q] = 0.f;
        for (int s = 0; s < 128; s += 4) { const float v0 = vn[s * 64 + c], v1 = vn[(s + 1) * 64 + c], v2 = vn[(s + 2) * 64 + c], v3 = vn[(s + 3) * 64 + c];
#pragma unroll
            for (int q = 0; q < 16; ++q) { const f32x4 w = *(const LAS f32x4*)(wsl + (t0 + q) * 128 + s); acc[q] += (w.x * v0 + w.y * v1) + (w.z * v2 + w.w * v3); } }
#pragma unroll
        for (int q = 0; q < 16; ++q) { const int row = n * 128 + t0 + q; const float u = bf2f(P[(size_t)row * EV_IN + 768 + g * 64 + c]);
            MX[(size_t)row * DM + 512 + g * 64 + c] = (bf16_t)f2bf(u * (acc[q] + BB[g * 128 + t0 + q])); }
    }
}

constexpr int NA_BIAS_OFF = 90112;
struct TMNA {
    int r4, lo; const LAS float* bt;
    DEV int row(int t) const { if (t < 4) return SEQ + 64 * t; int kr = lo + t - 4; kr = kr > 255 ? 255 : kr; return kr * GRIDW; }
    DEV void mask(attn_body::f32x16& p0, attn_body::f32x16& p1, int t, int wid, int r32, int hi) const {
        if (t < 4) return;
        asm volatile("" : "+v"(r32), "+v"(hi));
        const int kr = lo + t - 4, r = r4 + (wid >> 1); int rs = r - 4; rs = rs < 0 ? 0 : (rs > 248 ? 248 : rs);
        if (kr < rs || kr > rs + 7) {
#pragma unroll
            for (int q = 0; q < 16; ++q) { p0[q] = -INFINITY; p1[q] = -INFINITY; }
            return; }
        const int c = 32 * (wid & 1) + r32; int cs = c - 8; cs = cs < 0 ? 0 : (cs > 48 ? 48 : cs);
        const LAS float* bp = bt + (kr - r + 7) * 31 + 15 - c;
#pragma unroll
        for (int q4 = 0; q4 < 4; ++q4) {
#pragma unroll
            for (int q = 4 * q4; q < 4 * q4 + 4; ++q) { const int kc = (q & 3) + 8 * (q >> 2) + 4 * hi;
                p0[q] = ((unsigned)(kc - cs) <= 15u) ? p0[q] + bp[kc] : -INFINITY;
                p1[q] = ((unsigned)(kc + 32 - cs) <= 15u) ? p1[q] + bp[kc + 32] : -INFINITY; }
            asm volatile("" : "+v"(p0), "+v"(p1)); __builtin_amdgcn_sched_barrier(0); }
    }
};
DEV void phase_mix_odd(KArgsP a, const Fr& F, int i) {
    const bf16_t* P = (const bf16_t*)(a->ws + WS_P); bf16_t* MX = (bf16_t*)(a->ws + WS_MX);
    const float* rpb = a->in[I_RPB] + (size_t)i * 8 * 15 * 31;
    { typedef attn_body::bf16 abf; const int vcu = (F.G % 8 == 0) ? (F.bid % 8) * (F.G / 8) + F.bid / 8 : F.bid;
      LAS float* bt = (LAS float*)(F.lds + NA_BIAS_OFF);
      for (int e = F.tid; e < 8 * 15 * 31; e += NTHR) bt[e] = rpb[e] * 1.4426950408889634f;
      __syncthreads();
      for (int k = 0;; ++k) {
          int u; if (F.G == 256) u = k < 2 ? 2 * vcu + k : ((k == 2 && vcu < 8) ? 512 + vcu : -1); else u = (k * F.G + vcu < 520) ? k * F.G + vcu : -1;
          if (u < 0) break;
          if (u < 512) { const int h = u >> 6, r4 = (u & 63) * 4;
              int lo = r4 - 4; lo = lo < 0 ? 0 : (lo > 248 ? 248 : lo); int hi = r4 - 1; hi = hi < 0 ? 0 : (hi > 248 ? 248 : hi); hi += 7;
              const int nloc = (hi - lo + 2) & ~1;
              TMNA tm{r4, lo, bt + h * 465};
              attn_body::attn_unit<8, false>((const abf*)P + (size_t)(r4 * GRIDW) * OD_IN + h * 64, OD_IN, (const abf*)P + 512 + h * 64, (const abf*)P + 1024 + h * 64, OD_IN,
                                      (abf*)MX + (size_t)(r4 * GRIDW) * DM + h * 64, DM, 4 + nloc, tm, F.tid, (char*)F.lds);
          } else { const int h = u - 512;
              attn_body::attn_unit<8, true>((const abf*)P + (size_t)SEQ * OD_IN + h * 64, OD_IN, (const abf*)P + 512 + h * 64, (const abf*)P + 1024 + h * 64, OD_IN,
                                      (abf*)MX + (size_t)SEQ * DM + h * 64, DM, NCTX / 64, TMDense{}, F.tid, (char*)F.lds); }
      } }
}
DEV void phase_mix_odd_b(KArgsP a, const Fr& F, int i) {
    const bf16_t* P = (const bf16_t*)(a->ws + WS_P); bf16_t* MX = (bf16_t*)(a->ws + WS_MX);
    const float* DW = a->in[I_DDW] + (size_t)i * 31 * 512; const float* DB = a->in[I_DDWB] + i * 512;
    const float* LG = a->in[I_DLNG] + i * 512; const float* LB = a->in[I_DLNB] + i * 512;
    for (int row = F.gw; row < NTOK; row += F.NGW) {
        const int lo = row < SEQ ? 0 : SEQ, hi = row < SEQ ? SEQ : NTOK, ch = 8 * F.lane;
        float acc[8];
#pragma unroll
        for (int j = 0; j < 8; ++j) acc[j] = DB[ch + j];
        for (int w = 0; w < 31; ++w) { const int tt = row + w - 15; if (tt < lo || tt >= hi) continue;
            float y[8]; unpack8(*(const bf16x8*)(P + (size_t)tt * OD_IN + 1536 + ch), y);
            const f32x4 w0 = *(const f32x4*)(DW + w * 512 + ch), w1 = *(const f32x4*)(DW + w * 512 + ch + 4);
            acc[0] += y[0] * w0.x; acc[1] += y[1] * w0.y; acc[2] += y[2] * w0.z; acc[3] += y[3] * w0.w; acc[4] += y[4] * w1.x; acc[5] += y[5] * w1.y; acc[6] += y[6] * w1.z; acc[7] += y[7] * w1.w; }
        float s = 0.f;
#pragma unroll
        for (int j = 0; j < 8; ++j) s += acc[j];
        const float mean = wave_sum(s) * (1.f / 512.f); float q = 0.f;
#pragma unroll
        for (int j = 0; j < 8; ++j) { acc[j] -= mean; q += acc[j] * acc[j]; }
        const float rstd = rsqrtf(wave_sum(q) * (1.f / 512.f) + EPS);
#pragma unroll
        for (int j = 0; j < 8; ++j) acc[j] = siluf_(acc[j] * rstd * LG[ch + j] + LB[ch + j]);
        *(u32x4*)(MX + (size_t)row * DM + 512 + ch) = pack8(acc);
    }
}

DEV void phase_norm2(KArgsP a, const Fr& F, int l) {
    const int ntok = l < DEPTH - 1 ? NTOK : SEQ, rpw = (ntok + F.G - 1) / F.G;
    LAS float* rwt = (LAS float*)F.lds;
    LAS int* le = (LAS int*)(F.lds + 65536);
    for (int e = F.tid; e < 16384; e += NTHR) rwt[(e & 15) * 1024 + (e >> 4)] = a->in[I_RW][e];
    __syncthreads();
    bf16_t* H = (bf16_t*)(a->ws + WS_H); TokInfo* TI = (TokInfo*)(a->ws + WS_TOK);
    const int r0 = F.bid * rpw, r1 = (r0 + rpw < ntok) ? r0 + rpw : ntok;
    for (int row = r0 + F.wave; row < r1; row += NWAVES) {
        const float* xr = xrow_out(a, row); f32x4 v[4]; float s = 0.f;
#pragma unroll
        for (int j = 0; j < 4; ++j) { v[j] = ((const f32x4*)xr)[64 * j + F.lane]; s += (v[j].x * v[j].x + v[j].y * v[j].y) + (v[j].z * v[j].z + v[j].w * v[j].w); }
        const float rstd = rsqrtf(wave_sum(s) * (1.f / DM) + EPS);
        const float* g = a->in[I_N2G] + l * DM; const float* sc = modp(a, l, row, 4); const float* sh = modp(a, l, row, 3);
        float lg[16];
#pragma unroll
        for (int e = 0; e < 16; ++e) lg[e] = 0.f;
#pragma unroll
        for (int j = 0; j < 4; ++j) { const int c4 = 64 * j + F.lane; const f32x4 G = ((const f32x4*)g)[c4], SC = ((const f32x4*)sc)[c4], SH = ((const f32x4*)sh)[c4];
            const f32x4 o = v[j] * rstd * G * (SC + 1.f) + SH; u32x2 w; w.x = pk2(o.x, o.y); w.y = pk2(o.z, o.w); ((u32x2*)(H + (size_t)row * DM))[c4] = w;
#pragma unroll
            for (int e = 0; e < 16; ++e) { const f32x4 rw = *(const LAS f32x4*)(rwt + e * 1024 + 4 * c4); lg[e] += (o.x * rw.x + o.y * rw.y) + (o.z * rw.z + o.w * rw.w); } }
        float aff[16], sel[16];
#pragma unroll
        for (int e = 0; e < 16; ++e) { aff[e] = sigmoidf_(wave_sum(lg[e])); sel[e] = aff[e] + a->in[I_RB][e]; }
        int bg = 0; float bgs = -1e30f;
#pragma unroll
        for (int gq = 0; gq < 4; ++gq) { float m1 = -1e30f, m2 = -1e30f;
#pragma unroll
            for (int k = 0; k < 4; ++k) { const float x = sel[gq * 4 + k]; if (x > m1) { m2 = m1; m1 = x; } else if (x > m2) m2 = x; }
            const float gs = m1 + m2; if (gs > bgs) { bgs = gs; bg = gq; } }
        int e0 = 0, e1 = 0; float s0 = -1e30f, s1 = -1e30f, a0 = 0.f, a1 = 0.f;
#pragma unroll
        for (int e = 0; e < 16; ++e) { if ((e >> 2) == bg) { const float x = sel[e]; if (x > s0) { s1 = s0; e1 = e0; a1 = a0; s0 = x; e0 = e; a0 = aff[e]; } else if (x > s1) { s1 = x; e1 = e; a1 = aff[e]; } } }
        if (F.lane == 0) { const float inv = 1.f / (a0 + a1); TI[row].e0 = e0; TI[row].e1 = e1; TI[row].w0 = a0 * inv; TI[row].w1 = a1 * inv; le[row - r0] = e0; le[rpw + row - r0] = e1; }
    }
    __syncthreads();
    if (F.tid < 16) { const int e = F.tid; int cnt = 0;
        for (int j = 0; j < r1 - r0; ++j) { if (le[j] == e) TI[r0 + j].r0 = cnt++; else if (le[rpw + j] == e) TI[r0 + j].r1 = cnt++; }
        ((int*)(a->ws + WS_CNT))[F.bid * 16 + e] = cnt; }
}

DEV void phase_gather(KArgsP a, const Fr& F, int l) {
    const int ntok = l < DEPTH - 1 ? NTOK : SEQ, rpw = (ntok + F.G - 1) / F.G;
    LAS int* sb = (LAS int*)F.lds;
    const int* cnt = (const int*)(a->ws + WS_CNT);
    if (F.tid < 48) sb[F.tid] = 0;
    __syncthreads();
    { const int e = F.tid & 15; int base = 0, tot = 0;
      for (int w = F.tid >> 4; w < F.G; w += NTHR / 16) { const int c = cnt[w * 16 + e]; base += (w < F.bid) ? c : 0; tot += c; }
      atomicAdd((int*)(sb + e), base); atomicAdd((int*)(sb + 16 + e), tot); }
    __syncthreads();
    if (F.tid < 16) { int ps = 0;
#pragma unroll
        for (int e = 0; e < 16; ++e) { const int pc = (sb[16 + e] + 255) & ~255; if (e < F.tid) ps += pc; }
        sb[32 + F.tid] = ps; }
    __syncthreads();
    if (F.bid == 0 && F.tid <= MAXBLK) { int* blk = (int*)(a->ws + WS_BLK); const int b = F.tid - 1;
        const int pend15 = sb[32 + 15] + ((sb[16 + 15] + 255) & ~255);
        if (F.tid == 0) blk[0] = pend15 >> 8;
        else if (b * 256 < pend15) { int e = 0;
#pragma unroll
            for (int q = 1; q < 16; ++q) e += (sb[32 + q] <= b * 256) ? 1 : 0;
            blk[1 + b] = e; } }
    const bf16_t* H = (const bf16_t*)(a->ws + WS_H); bf16_t* BUF = (bf16_t*)(a->ws + WS_BUF); TokInfo* TI = (TokInfo*)(a->ws + WS_TOK);
    const int r0 = F.bid * rpw, r1 = (r0 + rpw < ntok) ? r0 + rpw : ntok;
    for (int row = r0 + F.wave; row < r1; row += NWAVES) {
        const TokInfo ti = TI[row];
        const int d0 = sb[32 + ti.e0] + sb[ti.e0] + ti.r0, d1 = sb[32 + ti.e1] + sb[ti.e1] + ti.r1;
        if (F.lane == 0) { TI[row].d0 = d0; TI[row].d1 = d1; }
        const u32x4* src = (const u32x4*)(H + (size_t)row * DM); const u32x4 v0 = src[F.lane], v1 = src[64 + F.lane];
        u32x4* q0 = (u32x4*)(BUF + (size_t)d0 * DM); u32x4* q1 = (u32x4*)(BUF + (size_t)d1 * DM);
        q0[F.lane] = v0; q0[64 + F.lane] = v1; q1[F.lane] = v0; q1[64 + F.lane] = v1;
    }
}

DEV void phase_gu_simple(KArgsP a, const Fr& F, int l) {
    const int* blk = (const int*)(a->ws + WS_BLK); const int nblk = blk[0];
    const bf16_t* BUF = (const bf16_t*)(a->ws + WS_BUF); bf16_t* ACT = (bf16_t*)(a->ws + WS_ACT);
    const int r32 = F.lane & 31, hi = F.lane >> 5;
    for (int t = F.gw; t < nblk * 128; t += F.NGW) {
        const int b = t >> 7, q = t & 127, mt = q >> 4, ct = q & 15, e = blk[1 + b];
        const bf16_t* W = (const bf16_t*)(a->ws + WS_WGU) + (size_t)(l * 16 + e) * 1024 * 1024;
        const int m0 = b * 256 + mt * 32, c0 = ct * 32, ng = 256 * (c0 / 128) + (c0 % 128);
        f32x16 ag = {}, au = {};
        const bf16_t* ap = BUF + (size_t)(m0 + r32) * DM + 8 * hi; const bf16_t* gp = W + (size_t)(ng + r32) * DM + 8 * hi; const bf16_t* up = gp + (size_t)128 * DM;
        for (int k = 0; k < DM; k += 16) { const bf16x8 av = *(const bf16x8*)(ap + k);
            ag = __builtin_amdgcn_mfma_f32_32x32x16_bf16(av, *(const bf16x8*)(gp + k), ag, 0, 0, 0); au = __builtin_amdgcn_mfma_f32_32x32x16_bf16(av, *(const bf16x8*)(up + k), au, 0, 0, 0); }
#pragma unroll
        for (int r = 0; r < 16; ++r) { const int row = m0 + (r & 3) + 8 * (r >> 2) + 4 * hi; ACT[(size_t)row * DEXP + c0 + r32] = (bf16_t)f2bf(siluf_(ag[r]) * au[r]); }
    }
}
DEV void phase_down_simple(KArgsP a, const Fr& F, int l) {
    const int* blk = (const int*)(a->ws + WS_BLK); const int nblk = blk[0];
    const bf16_t* ACT = (const bf16_t*)(a->ws + WS_ACT); bf16_t* Y = (bf16_t*)(a->ws + WS_P);
    const int r32 = F.lane & 31, hi = F.lane >> 5;
    for (int t = F.gw; t < nblk * 256; t += F.NGW) {
        const int b = t >> 8, q = t & 255, mt = q >> 5, nt = q & 31, e = blk[1 + b];
        const bf16_t* W = (const bf16_t*)(a->ws + WS_WDN) + (size_t)(l * 16 + e) * 1024 * 512;
        const int m0 = b * 256 + mt * 32, n0 = nt * 32; f32x16 acc = {};
        const bf16_t* ap = ACT + (size_t)(m0 + r32) * DEXP + 8 * hi; const bf16_t* bp = W + (size_t)(n0 + r32) * DEXP + 8 * hi;
        for (int k = 0; k < DEXP; k += 16) acc = __builtin_amdgcn_mfma_f32_32x32x16_bf16(*(const bf16x8*)(ap + k), *(const bf16x8*)(bp + k), acc, 0, 0, 0);
#pragma unroll
        for (int r = 0; r < 16; ++r) { const int row = m0 + (r & 3) + 8 * (r >> 2) + 4 * hi; Y[(size_t)row * DM + n0 + r32] = (bf16_t)f2bf(acc[r]); }
    }
}

DEV void phase_comb(KArgsP a, const Fr& F, int l) {
    const int ntok = l < DEPTH - 1 ? NTOK : SEQ;
    const bf16_t* Y = (const bf16_t*)(a->ws + WS_P); const TokInfo* TI = (const TokInfo*)(a->ws + WS_TOK); bf16_t* H = (bf16_t*)(a->ws + WS_H);
    for (int row = F.gw; row < ntok; row += F.NGW) {
        const TokInfo ti = TI[row]; float* xr = xrow_out(a, row); const float* g2 = modp(a, l, row, 5);
        const u32x2* y0 = (const u32x2*)(Y + (size_t)ti.d0 * DM); const u32x2* y1 = (const u32x2*)(Y + (size_t)ti.d1 * DM);
        f32x4 v[4];
#pragma unroll
        for (int j = 0; j < 4; ++j) { const int c4 = 64 * j + F.lane; const f32x4 x = ((const f32x4*)xr)[c4], G = ((const f32x4*)g2)[c4]; const u32x2 p0 = y0[c4], p1 = y1[c4];
            f32x4 f; f.x = ti.w0 * __uint_as_float(p0.x << 16) + ti.w1 * __uint_as_float(p1.x << 16); f.y = ti.w0 * __uint_as_float(p0.x & 0xffff0000u) + ti.w1 * __uint_as_float(p1.x & 0xffff0000u);
            f.z = ti.w0 * __uint_as_float(p0.y << 16) + ti.w1 * __uint_as_float(p1.y << 16); f.w = ti.w0 * __uint_as_float(p0.y & 0xffff0000u) + ti.w1 * __uint_as_float(p1.y & 0xffff0000u);
            v[j] = x + G * f; ((f32x4*)xr)[c4] = v[j]; }
        if (l < DEPTH - 1) modnorm_regs(v, a->in[I_N1G] + (l + 1) * DM, modp(a, l + 1, row, 1), modp(a, l + 1, row, 0), H + (size_t)row * DM, F.lane);
    }
}

#define XB_TMO      128
#define XB_XCNT(j)  (256  + 64 * (j))
#define XB_XSUB(j)  (1280 + 64 * (j))
#define XB_XGEN(j)  (2304 + 64 * (j))
#define XB_TOP      3328
#define XB_TOPGEN   3392
#define XCD_BAR_WORDS 3456
#define XB_SPIN_CAP (1u << 22)
DEV unsigned xb_ld(unsigned* p)              { return __hip_atomic_load(p, __ATOMIC_RELAXED, __HIP_MEMORY_SCOPE_AGENT); }
DEV unsigned xb_add(unsigned* p, unsigned v) { return __hip_atomic_fetch_add(p, v, __ATOMIC_RELAXED, __HIP_MEMORY_SCOPE_AGENT); }
DEV unsigned xb_xcc_id() { return (unsigned)__builtin_amdgcn_s_getreg((3 << 11) | 20) & 0xFu; }
#define XB_SPIN(cond, bar) do { unsigned _sp = 0; while (cond) { __builtin_amdgcn_s_sleep(1); \
    if ((++_sp & 255u) == 0u) { if (xb_ld(&(bar)[XB_TMO])) break; if (_sp > XB_SPIN_CAP) { atomicAdd(&(bar)[XB_TMO], 1u); break; } } } } while (0)
struct XcdBarrier { unsigned* bar; unsigned x; volatile LAS unsigned* st; };
DEV XcdBarrier xcd_barrier_post(unsigned* bar, volatile LAS unsigned* st) {
    XcdBarrier b; b.bar = bar; b.x = xb_xcc_id(); b.st = st;
    if (threadIdx.x == 0) (void)xb_add(&bar[XB_XCNT(b.x)], 1u);
    return b;
}
DEV void xcd_barrier_complete(unsigned* bar, unsigned x, unsigned& nloc, unsigned& nx) {
    const unsigned G = gridDim.x * gridDim.y * gridDim.z;
    unsigned sum, cnt, mine, sp = 0u;
    for (;;) {
        sum = 0u; cnt = 0u; mine = 0u;
#pragma unroll
        for (unsigned j = 0; j < 16; ++j) { const unsigned c = xb_ld(&bar[XB_XCNT(j)]); sum += c; cnt += (c > 0u) ? 1u : 0u; mine = (j == x) ? c : mine; }
        if (sum == G) break;
        __builtin_amdgcn_s_sleep(1);
        if ((++sp & 255u) == 0u) { if (xb_ld(&bar[XB_TMO])) break; if (sp > XB_SPIN_CAP) { atomicAdd(&bar[XB_TMO], 1u); break; } }
    }
    nloc = mine > 0u ? mine : 1u; nx = cnt > 0u ? cnt : 1u;
}
DEV void xcd_barrier(const XcdBarrier& b) {
    asm volatile("s_waitcnt vmcnt(0)" ::: "memory");
    __syncthreads();
    if (threadIdx.x == 0) {
        unsigned* bar = b.bar;
        __builtin_amdgcn_s_waitcnt(0);
        unsigned nloc = b.st[0], nx = b.st[1];
        if (nloc == 0u) { xcd_barrier_complete(bar, b.x, nloc, nx); b.st[0] = nloc; b.st[1] = nx; }
        const unsigned old = xb_add(&bar[XB_XSUB(b.x)], 1u);
        const unsigned gen = old / nloc;
        if (old + 1u == (gen + 1u) * nloc) {
            __builtin_amdgcn_fence(__ATOMIC_RELEASE, "agent");
            asm volatile("s_waitcnt vmcnt(0)" ::: "memory");
            const unsigned og = xb_add(&bar[XB_TOP], 1u);
            const unsigned tg = og / nx;
            if (og + 1u == (tg + 1u) * nx) xb_add(&bar[XB_TOPGEN], 1u);
            else XB_SPIN(xb_ld(&bar[XB_TOPGEN]) == tg, bar);
            __builtin_amdgcn_fence(__ATOMIC_ACQUIRE, "agent");
            xb_add(&bar[XB_XGEN(b.x)], 1u);
            asm volatile("s_waitcnt vmcnt(0)" ::: "memory");
        } else {
            XB_SPIN(xb_ld(&bar[XB_XGEN(b.x)]) == gen, bar);
            __builtin_amdgcn_fence(__ATOMIC_ACQUIRE, "agent");
            asm volatile("s_waitcnt vmcnt(0)" ::: "memory");
        }
    }
    __syncthreads();
}

constexpr int NPH = 2 + 9 * DEPTH;
__global__ void __launch_bounds__(NTHR, 2) mega(KArgs a_unused) {
    extern __shared__ __attribute__((aligned(16))) unsigned char lds_raw[];
#define FRAME() Fr F; { int t_ = threadIdx.x; asm volatile("" : "+v"(t_)); int b_ = blockIdx.x; asm volatile("" : "+s"(b_)); F.tid = t_; F.lane = t_ & 63; F.wave = __builtin_amdgcn_readfirstlane(t_ >> 6); F.bid = b_; F.G = gridDim.x; \
      F.gw = F.bid * NWAVES + F.wave; F.NGW = F.G * NWAVES; F.lds = (LAS unsigned char*)lds_raw; }
#define IN(k) (lo <= (k) && (k) < hi)
    int lo, hi; XcdBarrier bar;
    { KArgsP a = kargs(); lo = a->ph_lo; hi = a->ph_hi;
      volatile LAS unsigned* st = (volatile LAS unsigned*)((LAS unsigned char*)lds_raw + LDS_BYTES - 64);
      if (threadIdx.x < 16) st[threadIdx.x] = 0u;
      __syncthreads();
      bar = xcd_barrier_post((unsigned*)(a->ws + WS_CTL) + 4096, st); }
#define SEAM(k) do { if ((k) + 1 < hi) xcd_barrier(bar); } while (0)
    if (IN(0)) REPS(100) { FRAME(); phase_pro_a(kargs(), F); SEAM(0); }
    if (IN(1)) REPS(101) { FRAME(); phase_pro_b(kargs(), F); SEAM(1); }
    for (int l = 0; l < DEPTH; ++l) {
        const int pb = 2 + 9 * l, i = l >> 1; const bool even = (l & 1) == 0;
        if (IN(pb + 0)) REPS(0) { FRAME(); KArgsP a = kargs();
            const bf16_t* Hh = (const bf16_t*)(a->ws + WS_H); bf16_t* Pp = (bf16_t*)(a->ws + WS_P);
            const bf16_t* Wt = even ? (const bf16_t*)(a->ws + WS_WEVIN) + (size_t)i * EV_IN * DM : (const bf16_t*)(a->ws + WS_WODIN) + (size_t)i * OD_IN * DM;
            const int N = even ? EV_IN : OD_IN;
            { pg8::Gemm g{Hh, Wt, SEQ, N, DM}; pg8::StaticOrder S; S.init(SEQ, N, F.G, F.bid); pg8::EpiBf16 E{Pp, N};
              pg8::gemm_phase<pg8::EpiBf16, pg8::StaticOrder, true, true>(F.lds, g, S, E, F.tid); }
            gemm_simple(Hh + (size_t)SEQ * DM, Wt, NCTX, N, DM, EpiP{Pp, N}, F, SEQ);
            SEAM(pb + 0); }
        if (IN(pb + 1)) { FRAME(); if (even) phase_pre_even(kargs(), F, i); else phase_pre_odd(kargs(), F, i); SEAM(pb + 1); }
        if (IN(pb + 2)) REPS(2) {
            { FRAME(); if (even) phase_mix_even(kargs(), F, i); else phase_mix_odd(kargs(), F, i); }
            { FRAME(); if (even) phase_mix_even_b(kargs(), F, i); else phase_mix_odd_b(kargs(), F, i); }
            SEAM(pb + 2); }
        if (IN(pb + 3)) { FRAME(); KArgsP a = kargs();
            const bf16_t* Mm = (const bf16_t*)(a->ws + WS_MX); const bf16_t* Wt = (const bf16_t*)(a->ws + (even ? WS_WEVOUT : WS_WODOUT)) + (size_t)i * DM * DM;
            { pg8::Gemm g{Mm, Wt, SEQ, DM, DM}; pg8::StaticOrder S; S.init(SEQ, DM, F.G, F.bid); pg8::EpiResF32 E{xrow_in(a, l, 0), a->out, modp(a, l, 0, 2)};
              pg8::gemm_phase<pg8::EpiResF32, pg8::StaticOrder, true, true>(F.lds, g, S, E, F.tid); }
            gemm_simple(Mm + (size_t)SEQ * DM, Wt, NCTX, DM, DM, EpiRes{a, l}, F, SEQ);
            SEAM(pb + 3); }
        if (IN(pb + 4)) REPS(4) { FRAME(); phase_norm2(kargs(), F, l); SEAM(pb + 4); }
        if (IN(pb + 5)) REPS(5) { FRAME(); phase_gather(kargs(), F, l); SEAM(pb + 5); }
        if (IN(pb + 6)) REPS(6) { FRAME(); KArgsP a = kargs(); const int* blk = (const int*)(a->ws + WS_BLK);
            const int nblk = __builtin_amdgcn_readfirstlane((int)__hip_atomic_load((const unsigned*)blk, __ATOMIC_RELAXED, __HIP_MEMORY_SCOPE_AGENT));
            pg8::Gemm g{(const bf16_t*)(a->ws + WS_BUF), (const bf16_t*)(a->ws + WS_WGU) + (size_t)l * 16 * 1024 * 1024, nblk * 256, 1024, DM};
            pg8::GroupedOrder S{nblk * 4, F.G, F.bid, 4, blk, 2l * 1024 * 1024}; pg8::EpiGU E{(bf16_t*)(a->ws + WS_ACT)};
            pg8::gemm_phase<pg8::EpiGU, pg8::GroupedOrder, true, true>(F.lds, g, S, E, F.tid);
            SEAM(pb + 6); }
        if (IN(pb + 7)) REPS(7) { FRAME(); KArgsP a = kargs(); const int* blk = (const int*)(a->ws + WS_BLK);
            const int nblk = __builtin_amdgcn_readfirstlane((int)__hip_atomic_load((const unsigned*)blk, __ATOMIC_RELAXED, __HIP_MEMORY_SCOPE_AGENT));
            pg8::Gemm g{(const bf16_t*)(a->ws + WS_ACT), (const bf16_t*)(a->ws + WS_WDN) + (size_t)l * 16 * 1024 * 512, nblk * 256, 1024, DEXP};
            pg8::GroupedOrder S{nblk * 4, F.G, F.bid, 4, blk, 1l * 1024 * 1024}; pg8::EpiBf16 E{(bf16_t*)(a->ws + WS_P), DM};
            pg8::gemm_phase<pg8::EpiBf16, pg8::GroupedOrder, true, true>(F.lds, g, S, E, F.tid);
            SEAM(pb + 7); }
        if (IN(pb + 8)) { FRAME(); phase_comb(kargs(), F, l); SEAM(pb + 8); }
    }
#undef IN
#ifdef DBG_STOP
    { FRAME(); KArgsP a = kargs(); xcd_barrier(bar); const bf16_t* src = (const bf16_t*)(a->ws + DBG_SRC); float* o = a->out;
      for (size_t i = (size_t)F.bid * NTHR + F.tid; i < (size_t)SEQ * DM; i += (size_t)F.G * NTHR) o[i] = bf2f(src[i]); }
#endif
}

extern "C" void kernel_launch(void* const* d_in, const int* in_sizes, int n_in, void* d_out, int out_size, void* d_ws, size_t ws_size, hipStream_t stream) {
    static int grid = 0;
    if (grid == 0) {
        if (n_in != 29 || out_size != SEQ * DM || ws_size < WS_END) { fprintf(stderr, "kernel_launch: unexpected problem (n_in %d, out %d, ws %zu)\n", n_in, out_size, ws_size); grid = -1; return; }
        int dev = 0, cus = 0, per_cu = 0;
        if (hipGetDevice(&dev) != hipSuccess || hipDeviceGetAttribute(&cus, hipDeviceAttributeMultiprocessorCount, dev) != hipSuccess) { grid = -1; return; }
        if (hipFuncSetAttribute((const void*)mega, hipFuncAttributeMaxDynamicSharedMemorySize, LDS_BYTES) != hipSuccess) { fprintf(stderr, "kernel_launch: hipFuncSetAttribute failed\n"); grid = -1; return; }
        if (hipOccupancyMaxActiveBlocksPerMultiprocessor(&per_cu, (const void*)mega, NTHR, LDS_BYTES) != hipSuccess || per_cu < 1) { fprintf(stderr, "kernel_launch: occupancy query says %d\n", per_cu); (void)hipGetLastError(); }
        grid = cus;
    }
    if (grid < 0) return;
    KArgs a{};
    for (int i = 0; i < 29; ++i) a.in[i] = (const float*)d_in[i];
    a.out = (float*)d_out; a.ws = (unsigned char*)d_ws;
    (void)hipMemsetAsync((char*)d_ws + WS_CTL, 0, CTL_BYTES, stream);
#if N_LAUNCHES == 1
    a.ph_lo = 0; a.ph_hi = NPH; hipLaunchKernelGGL(mega, dim3(grid), dim3(NTHR), LDS_BYTES, stream, a);
#else
    for (int ph = 0; ph < NPH; ++ph) { a.ph_lo = ph; a.ph_hi = ph + 1; hipLaunchKernelGGL(mega, dim3(grid), dim3(NTHR), LDS_BYTES, stream, a); }
#endif
}
```

```cpp
#include <hip/hip_runtime.h>
#include <hip/hip_bf16.h>
#include <cmath>
#include <cstdint>
#include <cstdio>

#define DEV __device__ __forceinline__
#define LAS __attribute__((address_space(3)))
typedef unsigned short bf16_t;
typedef short bf16x8 __attribute__((ext_vector_type(8)));
typedef float f32x4 __attribute__((ext_vector_type(4)));
typedef float f32x2 __attribute__((ext_vector_type(2)));
typedef float f32x16 __attribute__((ext_vector_type(16)));
typedef unsigned u32x4 __attribute__((ext_vector_type(4)));
typedef unsigned u32x2 __attribute__((ext_vector_type(2)));

constexpr int DM = 1024, SEQ = 16384, NCTX = 256, NTOK = SEQ + NCTX, DEPTH = 4, GRIDW = 64;
constexpr int EV_IN = 1792, OD_IN = 2560, NEXP = 16, DEXP = 512;
constexpr int MAXBLK = 146;
constexpr float EPS = 1e-6f;
constexpr float ATT_C2 = 0.125f * 1.4426950408889634f;
constexpr int NWAVES = 8, NTHR = 512;
constexpr int GRID = 256;

constexpr size_t MiB = 1u << 20;
constexpr size_t WS_CTL = 0, CTL_BYTES = 1 * MiB;
constexpr size_t WS_MOD = 1 * MiB;
constexpr size_t WS_ROPE = 1 * MiB + 256 * 1024;
constexpr size_t WS_RWT = 1 * MiB + 320 * 1024;
constexpr size_t WS_CNT = 1 * MiB + 512 * 1024;
constexpr size_t WS_BLK = 1 * MiB + 768 * 1024;
constexpr size_t WS_TOK = 2 * MiB;
constexpr size_t WS_XCTX = 3 * MiB;
constexpr size_t WS_WEVIN = 4 * MiB;
constexpr size_t WS_WEVOUT = 11 * MiB;
constexpr size_t WS_WODIN = 15 * MiB;
constexpr size_t WS_WODOUT = 25 * MiB;
constexpr size_t WS_BWS = 29 * MiB;
constexpr size_t WS_WGU = 30 * MiB;
constexpr size_t WS_WDN = 158 * MiB;
constexpr size_t WS_H = 222 * MiB;
constexpr size_t WS_P = 255 * MiB;
constexpr size_t WS_MX = 337 * MiB;
constexpr size_t WS_BUF = 370 * MiB;
constexpr size_t WS_ACT = 443 * MiB;
constexpr size_t WS_END = 480 * MiB;
static_assert(WS_H + (size_t)NTOK * DM * 2 <= WS_P && WS_P + (size_t)NTOK * OD_IN * 2 <= WS_MX && WS_P + (size_t)MAXBLK * 256 * DM * 2 <= WS_MX, "ws map");
static_assert(WS_MX + (size_t)NTOK * DM * 2 <= WS_BUF && WS_BUF + (size_t)MAXBLK * 256 * DM * 2 <= WS_ACT && WS_ACT + (size_t)MAXBLK * 256 * DEXP * 2 <= WS_END, "ws map");

constexpr int LDS_BYTES = 147456;
#define REP_S -1
#define REPS(s) for (int rr_ = 0; rr_ < ((REP_S) == (s) ? 2 : 1); ++rr_)
#ifndef N_LAUNCHES
#define N_LAUNCHES 1
#endif

struct TokInfo { int e0, e1; float w0, w1; int r0, r1, d0, d1; };
struct KArgs { const float* in[29]; float* out; unsigned char* ws; int ph_lo, ph_hi; };
enum { I_X = 0, I_C, I_CTX, I_CCTX, I_RW, I_RB, I_ADAW, I_ADAB, I_N1G, I_N2G, I_EVIN, I_EVOUT, I_AQN, I_AKN, I_BVN, I_BWS, I_BBS,
       I_ODIN, I_ODOUT, I_CQN, I_CKN, I_RPB, I_DDW, I_DDWB, I_DLNG, I_DLNB, I_MG, I_MU, I_MD };

DEV float bf2f(bf16_t v) { return __uint_as_float((unsigned)v << 16); }
DEV float bf2f_s(short v) { return __uint_as_float(((unsigned)(unsigned short)v) << 16); }
DEV unsigned f2bf(float f) { unsigned u = __float_as_uint(f); return (u + 0x7fffu + ((u >> 16) & 1u)) >> 16; }
DEV unsigned pk2(float lo, float hi) { return f2bf(lo) | (f2bf(hi) << 16); }
template <int M> DEV float shx(float v) {
    if constexpr (M == 32) { auto rr = __builtin_amdgcn_permlane32_swap(__float_as_uint(v), __float_as_uint(v), false, false);
        unsigned m_ = ~0u; asm volatile("" : "+s"(m_)); const bool hi = __builtin_amdgcn_mbcnt_hi(m_, __builtin_amdgcn_mbcnt_lo(m_, 0u)) >= 32; return __uint_as_float(hi ? rr[0] : rr[1]); }
    else return __int_as_float(__builtin_amdgcn_ds_swizzle(__float_as_int(v), 0x1F | (M << 10)));
}
DEV float wave_sum(float v) {
    v += shx<1>(v); v += shx<2>(v); v += shx<4>(v); v += shx<8>(v); v += shx<16>(v);
    auto rr = __builtin_amdgcn_permlane32_swap(__float_as_uint(v), __float_as_uint(v), false, false);
    return __uint_as_float(rr[0]) + __uint_as_float(rr[1]);
}
DEV float sigmoidf_(float x) { return 1.f / (1.f + __expf(-x)); }
DEV float siluf_(float x) { return x / (1.f + __expf(-x)); }
DEV float gelu_tanh(float x) { const float u = 0.7978845608028654f * (x + 0.044715f * x * x * x); const float t = 1.f - 2.f / (__expf(2.f * u) + 1.f); return 0.5f * x * (1.f + t); }
DEV void unpack8(const bf16x8 v, float* f) {
#pragma unroll
    for (int j = 0; j < 8; ++j) f[j] = bf2f_s(v[j]);
}
DEV u32x4 pack8(const float* f) { u32x4 o; o.x = pk2(f[0], f[1]); o.y = pk2(f[2], f[3]); o.z = pk2(f[4], f[5]); o.w = pk2(f[6], f[7]); return o; }

typedef const __attribute__((address_space(4))) KArgs* KArgsP;
DEV KArgsP kargs() { KArgsP p = (KArgsP)__builtin_amdgcn_kernarg_segment_ptr(); asm volatile("" : "+s"(p)); return p; }
DEV int lane_id_fresh() { unsigned m_ = ~0u; asm volatile("" : "+s"(m_)); return __builtin_amdgcn_mbcnt_hi(m_, __builtin_amdgcn_mbcnt_lo(m_, 0u)); }
struct Fr { int tid, lane, wave, bid, gw; LAS unsigned char* lds; static constexpr int G = GRID, NGW = GRID * NWAVES; };

DEV const float* xrow_in(KArgsP a, int l, int row) {
    if (l == 0) return row < SEQ ? a->in[I_X] + (size_t)row * DM : a->in[I_CTX] + (size_t)(row - SEQ) * DM;
    return row < SEQ ? a->out + (size_t)row * DM : (const float*)(a->ws + WS_XCTX) + (size_t)(row - SEQ) * DM;
}
DEV float* xrow_out(KArgsP a, int row) { return row < SEQ ? a->out + (size_t)row * DM : (float*)(a->ws + WS_XCTX) + (size_t)(row - SEQ) * DM; }
DEV const float* modp(KArgsP a, int l, int row, int j) { return (const float*)(a->ws + WS_MOD) + (size_t)(l * 2 + (row < SEQ ? 0 : 1)) * 6144 + j * 1024; }

DEV void transpose_item(const float* W, int K, int N, int k0, int n0, bf16_t* drow0, LAS float* scr, int lane) {
#pragma unroll 8
    for (int i = 0; i < 32; ++i) { const int kk = 2 * i + (lane >> 5); scr[kk * 33 + (lane & 31)] = W[(size_t)(k0 + kk) * N + n0 + (lane & 31)]; }
    asm volatile("s_waitcnt lgkmcnt(0)" ::: "memory");
    const int c = lane & 7;
#pragma unroll
    for (int j = 0; j < 4; ++j) { const int n = (lane >> 3) + 8 * j; const LAS float* s = scr + (8 * c) * 33 + n;
        u32x4 o; o.x = pk2(s[0 * 33], s[1 * 33]); o.y = pk2(s[2 * 33], s[3 * 33]); o.z = pk2(s[4 * 33], s[5 * 33]); o.w = pk2(s[6 * 33], s[7 * 33]);
        *(u32x4*)(drow0 + (size_t)n * K + k0 + 8 * c) = o; }
    asm volatile("s_waitcnt lgkmcnt(0)" ::: "memory");
}

DEV void phase_pro_a(KArgsP a, const Fr& F) {
    LAS float* sl = (LAS float*)F.lds;
    LAS float* red = sl + 2048;
    float* mod = (float*)(a->ws + WS_MOD);
    bool loaded = false;
    for (int it = F.bid; it < 96; it += F.G) {
        if (!loaded) {
            for (int i = F.tid; i < 2048; i += NTHR) { const float v = i < 1024 ? a->in[I_C][i] : a->in[I_CCTX][i - 1024]; sl[i] = siluf_(v); }
            __syncthreads(); loaded = true;
        }
        const int l = it / 24, cg = it % 24, n0 = cg * 256 + 4 * F.lane;
        const float* W = a->in[I_ADAW] + (size_t)l * 1024 * 6144 + n0;
        f32x4 a0 = {0.f, 0.f, 0.f, 0.f}, a1 = {0.f, 0.f, 0.f, 0.f};
        const int kb = F.wave * 128;
#pragma unroll 8
        for (int k = 0; k < 128; ++k) { const f32x4 w = *(const f32x4*)(W + (size_t)(kb + k) * 6144); a0 += w * sl[kb + k]; a1 += w * sl[1024 + kb + k]; }
#pragma unroll
        for (int j = 0; j < 4; ++j) { red[(F.wave * 2 + 0) * 256 + 4 * F.lane + j] = a0[j]; red[(F.wave * 2 + 1) * 256 + 4 * F.lane + j] = a1[j]; }
        __syncthreads();
        { const int s = F.tid >> 8, n = F.tid & 255; float sum = a->in[I_ADAB][l * 6144 + cg * 256 + n];
#pragma unroll
          for (int w = 0; w < 8; ++w) sum += red[(w * 2 + s) * 256 + n];
          mod[(size_t)(l * 2 + s) * 6144 + cg * 256 + n] = sum; }
        __syncthreads();
    }
    if (F.bid == (F.G > 1 ? F.G - 2 : 0)) {
        float* rwt = (float*)(a->ws + WS_RWT);
        for (int e = F.tid; e < 16384; e += NTHR) rwt[(e & 15) * 1024 + (e >> 4)] = a->in[I_RW][e];
    }
    { bf16_t* bw = (bf16_t*)(a->ws + WS_BWS); const float* src = a->in[I_BWS];
      for (int e = (F.bid * NTHR + F.tid) * 4; e < 2 * 8 * 128 * 128; e += F.G * NTHR * 4) { const f32x4 v = *(const f32x4*)(src + e); u32x2 w; w.x = pk2(v.x, v.y); w.y = pk2(v.z, v.w); *(u32x2*)(bw + e) = w; } }
    if (F.bid == F.G - 1) {
        f32x2* tab = (f32x2*)(a->ws + WS_ROPE);
        for (int i = F.tid; i < 256 * 16; i += NTHR) { const int pos = i >> 4, f = i & 15;
            const float inv = exp2f(-(float)f * (13.287712379549449f / 16.f)); const float ang = (float)pos * inv;
            double rev = (double)ang * 0.15915494309189535; rev -= floor(rev); const float r = (float)rev;
            tab[i] = (f32x2){__builtin_amdgcn_cosf(r), __builtin_amdgcn_sinf(r)}; }
    }
    LAS float* scr = (LAS float*)(F.lds + 32768 + F.wave * 8448);
    constexpr int T0 = 2 * 896, T1 = T0 + 2 * 512, T2 = T1 + 2 * 1280, T3 = T2 + 2 * 512, T4 = T3 + 64 * 256, T5 = T4 + 64 * 256, T6 = T5 + 64 * 256;
    for (int it = F.gw; it < T6; it += F.NGW) {
        if (it < T0) { const int i = it / 896, r = it % 896; transpose_item(a->in[I_EVIN] + (size_t)i * 1024 * EV_IN, 1024, EV_IN, 64 * (r / 56), 32 * (r % 56), (bf16_t*)(a->ws + WS_WEVIN) + (size_t)i * EV_IN * 1024 + (size_t)(32 * (r % 56)) * 1024, scr, F.lane); }
        else if (it < T1) { const int q = it - T0, i = q / 512, r = q % 512; transpose_item(a->in[I_EVOUT] + (size_t)i * 1024 * 1024, 1024, 1024, 64 * (r / 32), 32 * (r % 32), (bf16_t*)(a->ws + WS_WEVOUT) + (size_t)i * 1024 * 1024 + (size_t)(32 * (r % 32)) * 1024, scr, F.lane); }
        else if (it < T2) { const int q = it - T1, i = q / 1280, r = q % 1280; transpose_item(a->in[I_ODIN] + (size_t)i * 1024 * OD_IN, 1024, OD_IN, 64 * (r / 80), 32 * (r % 80), (bf16_t*)(a->ws + WS_WODIN) + (size_t)i * OD_IN * 1024 + (size_t)(32 * (r % 80)) * 1024, scr, F.lane); }
        else if (it < T3) { const int q = it - T2, i = q / 512, r = q % 512; transpose_item(a->in[I_ODOUT] + (size_t)i * 1024 * 1024, 1024, 1024, 64 * (r / 32), 32 * (r % 32), (bf16_t*)(a->ws + WS_WODOUT) + (size_t)i * 1024 * 1024 + (size_t)(32 * (r % 32)) * 1024, scr, F.lane); }
        else if (it < T5) { const bool up = it >= T4; const int q = it - (up ? T4 : T3), m = q / 256, r = q % 256, n0 = 32 * (r % 16);
            const int drow = 256 * (n0 / 128) + (up ? 128 : 0) + (n0 % 128);
            transpose_item(a->in[up ? I_MU : I_MG] + (size_t)m * 1024 * 512, 1024, 512, 64 * (r / 16), n0, (bf16_t*)(a->ws + WS_WGU) + (size_t)m * 1024 * 1024 + (size_t)drow * 1024, scr, F.lane); }
        else { const int q = it - T5, m = q / 256, r = q % 256, n0 = 32 * (r % 32);
            transpose_item(a->in[I_MD] + (size_t)m * 512 * 1024, 512, 1024, 64 * (r / 32), n0, (bf16_t*)(a->ws + WS_WDN) + (size_t)m * 1024 * 512 + (size_t)n0 * 512, scr, F.lane); }
    }
}

DEV void modnorm_regs(const f32x4 (&v)[4], const float* g, const float* sc, const float* sh, bf16_t* orow, int lane) {
    float s = 0.f;
#pragma unroll
    for (int j = 0; j < 4; ++j) s += (v[j].x * v[j].x + v[j].y * v[j].y) + (v[j].z * v[j].z + v[j].w * v[j].w);
    const float rstd = rsqrtf(wave_sum(s) * (1.f / DM) + EPS);
#pragma unroll
    for (int j = 0; j < 4; ++j) { const int c4 = 64 * j + lane; const f32x4 G = ((const f32x4*)g)[c4], SC = ((const f32x4*)sc)[c4], SH = ((const f32x4*)sh)[c4];
        const f32x4 o = v[j] * rstd * G * (SC + 1.f) + SH; u32x2 w; w.x = pk2(o.x, o.y); w.y = pk2(o.z, o.w); ((u32x2*)orow)[c4] = w; }
}

DEV void phase_pro_b(KArgsP a, const Fr& F) {
    bf16_t* H = (bf16_t*)(a->ws + WS_H);
    for (int row = F.gw; row < NTOK; row += 2 * F.NGW) {
        const int rowb = row + F.NGW; const bool hb = rowb < NTOK;
        const float* xa = xrow_in(a, 0, row); const float* xb = xrow_in(a, 0, hb ? rowb : row); f32x4 va[4], vb[4];
#pragma unroll
        for (int j = 0; j < 4; ++j) { va[j] = ((const f32x4*)xa)[64 * j + F.lane]; vb[j] = ((const f32x4*)xb)[64 * j + F.lane]; }
        modnorm_regs(va, a->in[I_N1G], modp(a, 0, row, 1), modp(a, 0, row, 0), H + (size_t)row * DM, F.lane);
        if (hb) modnorm_regs(vb, a->in[I_N1G], modp(a, 0, rowb, 1), modp(a, 0, rowb, 0), H + (size_t)rowb * DM, F.lane);
    }
}

template <class Epi> DEV void gemm_simple(const bf16_t* A, const bf16_t* Bt, int M, int N, int K, const Epi& E, const Fr& F, int rowbase = 0) {
    const int ntn = N / 32, total = (M / 32) * ntn, r32 = F.lane & 31, hi = F.lane >> 5;
    for (int t = F.gw; t < total; t += F.NGW) {
        const int m0 = (t / ntn) * 32, n0 = (t % ntn) * 32;
        f32x16 acc = {};
        const bf16_t* ap = A + (size_t)(m0 + r32) * K + 8 * hi; const bf16_t* bp = Bt + (size_t)(n0 + r32) * K + 8 * hi;
        for (int k = 0; k < K; k += 16) acc = __builtin_amdgcn_mfma_f32_32x32x16_bf16(*(const bf16x8*)(ap + k), *(const bf16x8*)(bp + k), acc, 0, 0, 0);
#pragma unroll
        for (int r = 0; r < 16; ++r) E(rowbase + m0 + (r & 3) + 8 * (r >> 2) + 4 * hi, n0 + r32, acc[r]);
    }
}
struct EpiP { bf16_t* P; int ldc; DEV void operator()(int row, int col, float v) const { P[(size_t)row * ldc + col] = (bf16_t)f2bf(v); } };
struct EpiRes { KArgsP a; int l; DEV void operator()(int row, int col, float v) const { const float* xi = xrow_in(a, l, row); float* xo = xrow_out(a, row); xo[col] = xi[col] + modp(a, l, row, 2)[col] * v; } };

namespace pg8 {
#define PG8_LAS __attribute__((address_space(3)))
typedef unsigned short bf16_t;
typedef short bf16x8 __attribute__((ext_vector_type(8)));
typedef float f32x4 __attribute__((ext_vector_type(4)));
typedef unsigned u32x4 __attribute__((ext_vector_type(4)));
constexpr int BM = 256, BK = 64, HALF = 128, HTB = HALF * BK * 2  , STAGE_BYTES = 8 * HTB, NXCD = 8, WGM = 8;

__host__ __device__ __forceinline__ int lds_byte(int r, int c) { const int st = (r >> 4) * 2 + (c >> 5), rr = r & 15, cc = c & 31, ob = rr * 64 + cc * 2; return st * 1024 + (ob ^ (((ob >> 9) & 1) << 5)); }
__host__ __device__ __forceinline__ void stage_rc(int b, int& R, int& C) { const int st = b / 1024, sb = b % 1024, swz = sb ^ (((sb >> 9) & 1) << 5); R = (st >> 1) * 16 + swz / 64; C = (st & 1) * 32 + (swz % 64) / 2; }
__host__ __device__ __forceinline__ int perm32(int rho) { const int n = rho >> 4, i = rho & 15; return 8 * (i >> 2) + 4 * n + (i & 3); }

struct Unit { int pm, pn; long boff; };
struct Gemm { const bf16_t* A; const bf16_t* Bt; int M, N, K; };

struct StaticOrder {
    int nM, nN, nwg, G, c;
    __host__ __device__ void init(int M, int N, int G_, int c_) { nM = M / BM; nN = N / BM; nwg = nM * nN; G = G_; c = c_; }
    __host__ __device__ bool next(int i, Unit& u) const {
        const long L = (long)i * G + c; if (L >= nwg) return false;
        int wgid = (int)L; { const int q = nwg / NXCD, r = nwg % NXCD, xcd = wgid % NXCD, off = wgid / NXCD; wgid = (xcd < r ? xcd * (q + 1) : r * (q + 1) + (xcd - r) * q) + off; }
        const int nig = WGM * nN, gid = wgid / nig, fm = gid * WGM, gsz = (nM - fm) < WGM ? (nM - fm) : WGM;
        u.pm = fm + ((wgid % nig) % gsz); u.pn = (wgid % nig) / gsz; u.boff = 0; return true;
    }
    __device__ __forceinline__ void a_ready(const Unit&) const {}
    __device__ __forceinline__ void done(const Unit&) const {}
};


__device__ __forceinline__ unsigned cvt_pk_bf16(float lo, float hi) { unsigned r; asm volatile("v_cvt_pk_bf16_f32 %0, %1, %2" : "=v"(r) : "v"(lo), "v"(hi)); return r; }
struct EpiBf16 {
    static constexpr bool PERM = true, AFTER_DRAIN = false;
    bf16_t* O; int ldc;
    __device__ __forceinline__ void operator()(const f32x4 (&acc)[2][2][4][2], const Unit& u, int wr, int wc, int fr, int fq) const {
        const int row0 = u.pm * BM + wr * 64 + fr, col0 = u.pn * BM + wc * 32 + 8 * fq;
#pragma unroll
        for (int ai = 0; ai < 2; ++ai)
#pragma unroll
            for (int m = 0; m < 4; ++m) { bf16_t* rowp = O + (size_t)(row0 + ai * HALF + m * 16) * ldc + col0;
#pragma unroll
                for (int bj = 0; bj < 2; ++bj) { const f32x4 v0 = acc[ai][bj][m][0], v1 = acc[ai][bj][m][1];
                    u32x4 w; w.x = cvt_pk_bf16(v0[0], v0[1]); w.y = cvt_pk_bf16(v0[2], v0[3]); w.z = cvt_pk_bf16(v1[0], v1[1]); w.w = cvt_pk_bf16(v1[2], v1[3]);
                    *(u32x4*)(rowp + bj * HALF) = w; } }
    }
};
struct EpiGU {
    static constexpr bool PERM = true, AFTER_DRAIN = false;
    bf16_t* ACT;
    __device__ __forceinline__ void operator()(const f32x4 (&acc)[2][2][4][2], const Unit& u, int wr, int wc, int fr, int fq) const {
        const int row0 = u.pm * BM + wr * 64 + fr, col0 = u.pn * HALF + wc * 32 + 8 * fq;
#pragma unroll
        for (int ai = 0; ai < 2; ++ai)
#pragma unroll
            for (int m = 0; m < 4; ++m) { bf16_t* rowp = ACT + (size_t)(row0 + ai * HALF + m * 16) * 512 + col0; float o[8];
#pragma unroll
                for (int n = 0; n < 2; ++n)
#pragma unroll
                    for (int j = 0; j < 4; ++j) { const float gt = acc[ai][0][m][n][j], up = acc[ai][1][m][n][j]; o[4 * n + j] = gt * __builtin_amdgcn_rcpf(1.f + __expf(-gt)) * up; }
                u32x4 w; w.x = cvt_pk_bf16(o[0], o[1]); w.y = cvt_pk_bf16(o[2], o[3]); w.z = cvt_pk_bf16(o[4], o[5]); w.w = cvt_pk_bf16(o[6], o[7]);
                *(u32x4*)rowp = w; }
    }
};
struct EpiResF32 {
    static constexpr bool PERM = false, AFTER_DRAIN = false;
    const float* xi; float* xo; const float* gate;
    __device__ __forceinline__ void operator()(const f32x4 (&acc)[2][2][4][2], const Unit& u, int wr, int wc, int fr, int fq) const {
        const int row0 = u.pm * BM + wr * 64 + fr, col0 = u.pn * BM + wc * 32 + 4 * fq;
        f32x4 gv[2][2];
#pragma unroll
        for (int bj = 0; bj < 2; ++bj)
#pragma unroll
            for (int n = 0; n < 2; ++n) gv[bj][n] = *(const f32x4*)(gate + col0 + bj * HALF + n * 16);
#pragma unroll
        for (int ai = 0; ai < 2; ++ai)
#pragma unroll
            for (int m = 0; m < 4; ++m) { const size_t off = (size_t)(row0 + ai * HALF + m * 16) * 1024 + col0;
#pragma unroll
                for (int bj = 0; bj < 2; ++bj)
#pragma unroll
                    for (int n = 0; n < 2; ++n) *(f32x4*)(xo + off + bj * HALF + n * 16) = *(const f32x4*)(xi + off + bj * HALF + n * 16) + gv[bj][n] * acc[ai][bj][m][n]; }
    }
};
struct GroupedOrder {
    int nunits, G, c, nN; const int* blk; long wbytes;
    __device__ __forceinline__ bool next(int i, Unit& u) const {
        const long L = (long)i * G + c; if (L >= nunits) return false;
        const int b = (int)(L / nN); u.pm = b; u.pn = (int)(L % nN);
        const int e = __builtin_amdgcn_readfirstlane((int)__hip_atomic_load((const unsigned*)blk + 1 + b, __ATOMIC_RELAXED, __HIP_MEMORY_SCOPE_AGENT));
        u.boff = (long)e * wbytes; return true;
    }
    __device__ __forceinline__ void a_ready(const Unit&) const {}
    __device__ __forceinline__ void done(const Unit&) const {}
};

template <class Epi, class Sched, bool ALIGN_EPI = false, bool SP2 = false>
__device__ __forceinline__ void gemm_phase(PG8_LAS unsigned char* lds, const Gemm g, const Sched& S, const Epi& E, const int tid_in) {
    const int tid = tid_in, wid = __builtin_amdgcn_readfirstlane(tid >> 6), lane = tid & 63, wr = wid >> 2, wc = wid & 3, fr = lane & 15, fq = lane >> 4;
    const int K = g.K, nt = K / BK;
    unsigned voffA[2], voffB[2];
#pragma unroll
    for (int i = 0; i < 2; ++i) { int R, C; stage_rc(tid * 16 + i * 8192, R, C); const int Rb = Epi::PERM ? ((R & ~31) + perm32(R & 31)) : R;
        voffA[i] = (unsigned)(R * K + C) * 2u; voffB[i] = (unsigned)(Rb * K + C) * 2u; }
    const size_t kstep = (size_t)(BK * 2);
    const size_t hstep = (size_t)HALF * K * 2;
    const size_t tstep = 2 * hstep;
    const unsigned ldsw = (unsigned)wid * 1024u;
    const int aoff = lds_byte(wr * 64 + fr, fq * 8), boff = lds_byte(wc * 32 + fr, fq * 8);
#define PG8_SA(b, h) (((b) * 2 + (h)) * HTB)
#define PG8_SB(b, h) ((4 + (b) * 2 + (h)) * HTB)
#define PG8_STAGE(bufoff, gbase, voff) do { _Pragma("unroll") for (int _i = 0; _i < 2; ++_i) \
        __builtin_amdgcn_global_load_lds((const unsigned*)((const char*)(gbase) + (voff)[_i]), (PG8_LAS unsigned*)(lds + (bufoff) + ldsw + _i * 8192), 16, 0, 0); } while (0)
#define PG8_LDA(dst, b, h) do { _Pragma("unroll") for (int m = 0; m < 4; ++m) _Pragma("unroll") for (int k = 0; k < 2; ++k) dst[m][k] = *(const PG8_LAS bf16x8*)(lds + PG8_SA(b, h) + aoff + m * 2048 + k * 1024); } while (0)
#define PG8_LDB(dst, b, h) do { _Pragma("unroll") for (int n = 0; n < 2; ++n) _Pragma("unroll") for (int k = 0; k < 2; ++k) dst[n][k] = *(const PG8_LAS bf16x8*)(lds + PG8_SB(b, h) + boff + n * 2048 + k * 1024); } while (0)
#define PG8_MMA(ai, bj, At, Bt) do { __builtin_amdgcn_s_setprio(1); _Pragma("unroll") for (int m = 0; m < 4; ++m) _Pragma("unroll") for (int n = 0; n < 2; ++n) _Pragma("unroll") for (int k = 0; k < 2; ++k) \
        acc[ai][bj][m][n] = __builtin_amdgcn_mfma_f32_16x16x32_bf16(Bt[n][k], At[m][k], acc[ai][bj][m][n], 0, 0, 0); __builtin_amdgcn_s_setprio(0); } while (0)
#define PG8_WAIT_V(n) asm volatile("s_waitcnt vmcnt(" #n ")" ::: "memory")
#define PG8_WAIT_L(n) asm volatile("s_waitcnt lgkmcnt(" #n ")" ::: "memory")
#define PG8_BAR __builtin_amdgcn_s_barrier()
#define PG8_SCHED __builtin_amdgcn_sched_barrier(0)
    Unit cur, nxt; int ui = 0;
    if (!S.next(0, cur)) return;
    f32x4 acc[2][2][4][2];
#pragma unroll
    for (int a = 0; a < 2; ++a)
#pragma unroll
        for (int b = 0; b < 2; ++b)
#pragma unroll
            for (int m = 0; m < 4; ++m)
#pragma unroll
                for (int n = 0; n < 2; ++n) acc[a][b][m][n] = (f32x4){0.f, 0.f, 0.f, 0.f};
    bf16x8 At[4][2], B0[2][2], B1[2][2];
    const char* cA = (const char*)g.A + (size_t)cur.pm * tstep; const char* cB = (const char*)g.Bt + cur.boff + (size_t)cur.pn * tstep;
    S.a_ready(cur);
    if constexpr (SP2) {
        PG8_STAGE(PG8_SB(0, 0), cB, voffB); PG8_STAGE(PG8_SB(0, 1), cB + hstep, voffB); PG8_STAGE(PG8_SA(0, 0), cA, voffA); PG8_STAGE(PG8_SA(0, 1), cA + hstep, voffA);
        if (wr == 1) PG8_BAR;
        PG8_WAIT_V(2); PG8_BAR;
        PG8_STAGE(PG8_SB(1, 0), cB + kstep, voffB); PG8_STAGE(PG8_SA(1, 0), cA + kstep, voffA); PG8_STAGE(PG8_SB(1, 1), cB + hstep + kstep, voffB);
        PG8_WAIT_V(6); PG8_BAR;
    } else {
        PG8_STAGE(PG8_SB(0, 0), cB, voffB); PG8_STAGE(PG8_SA(0, 0), cA, voffA); PG8_STAGE(PG8_SB(0, 1), cB + hstep, voffB); PG8_STAGE(PG8_SA(0, 1), cA + hstep, voffA);
        if (wr == 1) PG8_BAR;
        PG8_WAIT_V(4); PG8_BAR;
        PG8_STAGE(PG8_SB(1, 0), cB + kstep, voffB); PG8_STAGE(PG8_SA(1, 0), cA + kstep, voffA); PG8_STAGE(PG8_SB(1, 1), cB + hstep + kstep, voffB);
        PG8_WAIT_V(6); PG8_BAR;
    }
    for (;;) {
        const bool has_next = S.next(ui + 1, nxt);
        const char* nA = has_next ? (const char*)g.A + (size_t)nxt.pm * tstep : cA; const char* nB = has_next ? (const char*)g.Bt + nxt.boff + (size_t)nxt.pn * tstep : cB;
        for (int t = 0; t < nt; t += 2) {
            const bool last = (t == nt - 2);
            const char* a1 = cA + (size_t)(t + 1) * kstep;
            const char* a2 = last ? nA : cA + (size_t)(t + 2) * kstep; const char* b2 = last ? nB : cB + (size_t)(t + 2) * kstep;
            const char* a3 = a2 + kstep; const char* b3 = b2 + kstep;
            if (last && has_next) S.a_ready(nxt);
            if constexpr (SP2) {
            PG8_LDB(B0, 0, 0); PG8_LDB(B1, 0, 1); PG8_SCHED; PG8_LDA(At, 0, 0); PG8_STAGE(PG8_SA(1, 1), a1 + hstep, voffA);
            PG8_WAIT_V(8); PG8_WAIT_L(0); PG8_BAR; PG8_MMA(0, 0, At, B0); PG8_MMA(0, 1, At, B1); PG8_BAR; PG8_SCHED;
            PG8_LDA(At, 0, 1); PG8_STAGE(PG8_SB(0, 0), b2, voffB); PG8_STAGE(PG8_SB(0, 1), b2 + hstep, voffB); PG8_STAGE(PG8_SA(0, 0), a2, voffA);
            PG8_WAIT_V(8); PG8_WAIT_L(0); PG8_BAR; PG8_MMA(1, 0, At, B0); PG8_MMA(1, 1, At, B1); PG8_BAR; PG8_SCHED;
            PG8_LDB(B0, 1, 0); PG8_LDB(B1, 1, 1); PG8_SCHED; PG8_LDA(At, 1, 0); PG8_STAGE(PG8_SA(0, 1), a2 + hstep, voffA);
            PG8_WAIT_V(8); PG8_WAIT_L(0); PG8_BAR; PG8_MMA(0, 0, At, B0); PG8_MMA(0, 1, At, B1); PG8_BAR; PG8_SCHED;
            PG8_LDA(At, 1, 1); PG8_STAGE(PG8_SB(1, 0), b3, voffB); PG8_STAGE(PG8_SB(1, 1), b3 + hstep, voffB); PG8_STAGE(PG8_SA(1, 0), a3, voffA);
            PG8_WAIT_V(8); PG8_WAIT_L(0); PG8_BAR; PG8_MMA(1, 0, At, B0); PG8_MMA(1, 1, At, B1); PG8_BAR; PG8_SCHED;
            } else {
            PG8_LDB(B0, 0, 0); PG8_SCHED; PG8_LDA(At, 0, 0); PG8_STAGE(PG8_SA(1, 1), a1 + hstep, voffA);
            PG8_WAIT_L(8); PG8_BAR; PG8_WAIT_L(0); PG8_MMA(0, 0, At, B0); PG8_BAR; PG8_SCHED;
            PG8_LDB(B1, 0, 1); PG8_STAGE(PG8_SB(0, 0), b2, voffB);
            PG8_BAR; PG8_WAIT_L(0); PG8_MMA(0, 1, At, B1); PG8_BAR;
            PG8_LDA(At, 0, 1); PG8_STAGE(PG8_SA(0, 0), a2, voffA);
            PG8_BAR; PG8_WAIT_L(0); PG8_MMA(1, 0, At, B0); PG8_BAR; PG8_SCHED;
            PG8_STAGE(PG8_SB(0, 1), b2 + hstep, voffB);
            PG8_WAIT_V(6); PG8_BAR; PG8_MMA(1, 1, At, B1); PG8_BAR;
            PG8_LDB(B0, 1, 0); PG8_SCHED; PG8_LDA(At, 1, 0); PG8_STAGE(PG8_SA(0, 1), a2 + hstep, voffA);
            PG8_WAIT_L(8); PG8_BAR; PG8_WAIT_L(0); PG8_MMA(0, 0, At, B0); PG8_BAR; PG8_SCHED;
            PG8_LDB(B1, 1, 1); PG8_STAGE(PG8_SB(1, 0), b3, voffB);
            PG8_BAR; PG8_WAIT_L(0); PG8_MMA(0, 1, At, B1); PG8_BAR;
            PG8_LDA(At, 1, 1); PG8_STAGE(PG8_SA(1, 0), a3, voffA);
            PG8_BAR; PG8_WAIT_L(0); PG8_MMA(1, 0, At, B0); PG8_BAR; PG8_SCHED;
            PG8_STAGE(PG8_SB(1, 1), b3 + hstep, voffB);
            PG8_WAIT_V(6); PG8_BAR; PG8_MMA(1, 1, At, B1); PG8_BAR;
            }
        }
        if constexpr (ALIGN_EPI) { if (wr == 0) PG8_BAR; }
        if constexpr (!Epi::AFTER_DRAIN) { E(acc, cur, wr, wc, fr, fq); S.done(cur); }
        if (!has_next) break;
#pragma unroll
        for (int a = 0; a < 2; ++a)
#pragma unroll
            for (int b = 0; b < 2; ++b)
#pragma unroll
                for (int m = 0; m < 4; ++m)
#pragma unroll
                    for (int n = 0; n < 2; ++n) acc[a][b][m][n] = (f32x4){0.f, 0.f, 0.f, 0.f};
        cur = nxt; cA = nA; cB = nB; ++ui;
        if constexpr (ALIGN_EPI) { if (wr == 1) PG8_BAR; }
    }
    PG8_WAIT_V(0);
    if constexpr (!ALIGN_EPI) { if (wr == 0) PG8_BAR; }
    PG8_BAR;
    if constexpr (Epi::AFTER_DRAIN) { E.fused(acc, cur, wr, wc, fr, fq, lds, wid, lane); S.done(cur); }
#undef PG8_SA
#undef PG8_SB
#undef PG8_STAGE
#undef PG8_LDA
#undef PG8_LDB
#undef PG8_MMA
#undef PG8_WAIT_V
#undef PG8_WAIT_L
#undef PG8_BAR
#undef PG8_SCHED
}

}

DEV void load64(const bf16_t* p, float* x) {
#pragma unroll
    for (int c = 0; c < 8; ++c) unpack8(((const bf16x8*)p)[c], x + 8 * c);
}
DEV void store64(bf16_t* p, const float* x) {
#pragma unroll
    for (int c = 0; c < 8; ++c) ((u32x4*)p)[c] = pack8(x + 8 * c);
}
DEV float sum8lanes(float v) { v += shx<1>(v); v += shx<2>(v); v += shx<4>(v); return v; }
DEV void pre_even_chunk(KArgsP a, int i, const f32x2* tab, int it, float (&x)[8]) {
    const int j8 = it & 7, gidx = it >> 3, row = gidx / 10, grp = gidx % 10;
    float ss = 0.f;
#pragma unroll
    for (int d = 0; d < 8; ++d) ss += x[d] * x[d];
    ss = sum8lanes(ss);
    const float r = rsqrtf(ss * (1.f / 64.f) + EPS) * (grp < 8 ? ATT_C2 : 1.f);
    const float* gn = a->in[grp < 8 ? I_AQN : I_AKN] + i * 64;
#pragma unroll
    for (int d = 0; d < 8; ++d) x[d] *= r * gn[8 * j8 + d];
    float y[8];
#pragma unroll
    for (int d = 0; d < 8; ++d) y[d] = shx<2>(x[d]);
    if (row < SEQ) {
        const int pos = (j8 & 4) ? (row % GRIDW) : (row / GRIDW); const bool second = (j8 & 2) != 0;
#pragma unroll
        for (int d = 0; d < 8; ++d) { const f32x2 cs = tab[pos * 16 + 8 * (j8 & 1) + d]; x[d] = second ? (x[d] * cs.x + y[d] * cs.y) : (x[d] * cs.x - y[d] * cs.y); }
    }
}
DEV bf16_t* pre_even_ptr(bf16_t* P, int it) { const int j8 = it & 7, gidx = it >> 3, row = gidx / 10, grp = gidx % 10; return P + (size_t)row * EV_IN + grp * 64 + 8 * j8; }
DEV void phase_pre_even(KArgsP a, const Fr& F, int i) {
    bf16_t* P = (bf16_t*)(a->ws + WS_P); const f32x2* tab = (const f32x2*)(a->ws + WS_ROPE);
    const int total = NTOK * 10 * 8, stride = F.G * NTHR;
    for (int it0 = F.bid * NTHR + F.tid; it0 < total; it0 += 4 * stride) {
        bf16x8 raw[4]; bf16_t* p[4];
#pragma unroll
        for (int u = 0; u < 4; ++u) { const int it = it0 + u * stride; p[u] = pre_even_ptr(P, it < total ? it : it0); raw[u] = *(const bf16x8*)p[u]; }
#pragma unroll
        for (int u = 0; u < 4; ++u) { const int it = it0 + u * stride; if (it < total) { float x[8]; unpack8(raw[u], x); pre_even_chunk(a, i, tab, it, x); *(u32x4*)p[u] = pack8(x); } }
    }
}
DEV bf16_t* pre_odd_ptr(bf16_t* P, int it) { const int j8 = it & 7, gidx = it >> 3, row = gidx / 24, gi = gidx % 24; return P + (size_t)row * OD_IN + (gi < 16 ? gi * 64 : 1536 + (gi - 16) * 64) + 8 * j8; }
DEV void phase_pre_odd(KArgsP a, const Fr& F, int i) {
    bf16_t* P = (bf16_t*)(a->ws + WS_P);
    const int total = NTOK * 24 * 8, stride = F.G * NTHR;
    for (int it0 = F.bid * NTHR + F.tid; it0 < total; it0 += 4 * stride) {
        bf16x8 raw[4], rawg[4]; bf16_t* p[4];
#pragma unroll
        for (int u = 0; u < 4; ++u) { const int it = it0 + u * stride, itc = it < total ? it : it0; p[u] = pre_odd_ptr(P, itc); raw[u] = *(const bf16x8*)p[u];
            rawg[u] = ((itc >> 3) % 24) >= 16 ? *(const bf16x8*)(p[u] + 512) : raw[u]; }
#pragma unroll
        for (int u = 0; u < 4; ++u) { const int it = it0 + u * stride; if (it < total) {
            const int j8 = it & 7, gi = (it >> 3) % 24; float x[8]; unpack8(raw[u], x);
            float ss = 0.f;
#pragma unroll
            for (int d = 0; d < 8; ++d) ss += x[d] * x[d];
            ss = sum8lanes(ss);
            if (gi < 16) {
                const float r = rsqrtf(ss * (1.f / 64.f) + EPS) * (gi < 8 ? ATT_C2 : 1.f); const float* gn = a->in[gi < 8 ? I_CQN : I_CKN] + i * 64;
#pragma unroll
                for (int d = 0; d < 8; ++d) x[d] *= r * gn[8 * j8 + d];
            } else {
                float xg[8]; unpack8(rawg[u], xg);
#pragma unroll
                for (int d = 0; d < 8; ++d) x[d] *= sigmoidf_(xg[d]);
            }
            *(u32x4*)p[u] = pack8(x); } }
    }
}

namespace attn_body {
using bf16=__hip_bfloat16;
using bf16x8=__attribute__((ext_vector_type(8)))short;
using s16x4=__attribute__((ext_vector_type(4)))short;
using f32x16=__attribute__((ext_vector_type(16)))float;
using u32x4=__attribute__((ext_vector_type(4)))unsigned;
constexpr int D=64;
constexpr int NW=8,QBLK=32,QB=QBLK*NW,KVBLK=64;
constexpr int ATTN_UNIT_ROWS=QB;
__device__ __forceinline__ int crow(int r,int hi){return (r&3)+8*(r>>2)+4*hi;}
#define SBAR() __builtin_amdgcn_sched_barrier(0)
__device__ __forceinline__ void cmask(f32x16&p0,f32x16&p1,int jb,int qrel,int hi){
  const float NEG=-INFINITY; int kb=64*jb+4*hi;
  #pragma unroll
  for(int r=0;r<16;++r){int kv=kb+(r&3)+8*(r>>2); if(kv>qrel)p0[r]=NEG; if(kv+32>qrel)p1[r]=NEG;}
}

constexpr int NSLOT=3, SLOTB=8192;
constexpr int LDS_K=0, LDS_V=NSLOT*SLOTB, LDS_WS=2*NSLOT*SLOTB, LDS_OST=LDS_WS+NW*64*4, LDS_BYTES=LDS_OST+NW*4096;
constexpr float C2=0.125f*1.4426950408889634f;
__device__ __forceinline__ void glds16(const void*gsrc,unsigned lds_dst){unsigned keep;
  asm volatile("s_mov_b32 %0, m0\n\ts_mov_b32 m0, %2\n\ts_nop 0\n\tglobal_load_lds_dwordx4 %1, off\n\ts_mov_b32 m0, %0":"=&s"(keep):"v"(gsrc),"s"(lds_dst):"memory");}
__device__ __forceinline__ float max3f(float a,float b,float c){float r;asm("v_max3_f32 %0, %1, %2, %3":"=v"(r):"v"(a),"v"(b),"v"(c));return r;}
__device__ __forceinline__ float max2f(float a,float b){float r;asm("v_max_f32_e32 %0, %1, %2":"=v"(r):"v"(a),"v"(b));return r;}
__device__ __forceinline__ float fadd_s(float a,float b){float r;asm("v_add_f32_e32 %0, %1, %2":"=v"(r):"v"(a),"v"(b));return r;}
__device__ __forceinline__ float fsub_s(float a,float b){float r;asm("v_sub_f32_e32 %0, %1, %2":"=v"(r):"v"(a),"v"(b));return r;}
typedef float f32x2_t __attribute__((ext_vector_type(2))); typedef __bf16 bf16x2_t __attribute__((ext_vector_type(2)));
__device__ __forceinline__ unsigned cvtpk_s(float lo,float hi){f32x2_t v={lo,hi};bf16x2_t b=__builtin_convertvector(v,bf16x2_t);return __builtin_bit_cast(unsigned,b);}
#define WAIT_BAR(N) asm volatile("s_waitcnt vmcnt(" #N ") lgkmcnt(0)\n\ts_barrier":::"memory")

__device__ __forceinline__ void qkt(f32x16&p0,f32x16&p1,const char*Kslot,const bf16x8*qr,const f32x16&negm,int r32,int hi){
  const char*kb=Kslot+hi*1024+r32*16;
  #pragma unroll
  for(int d0=0;d0<4;++d0){
    const bf16x8 b0=*reinterpret_cast<const bf16x8*>(kb+d0*2048);
    const bf16x8 b1=*reinterpret_cast<const bf16x8*>(kb+d0*2048+512);
    if(d0==0){p0=__builtin_amdgcn_mfma_f32_32x32x16_bf16(b0,qr[0],negm,0,0,0);p1=__builtin_amdgcn_mfma_f32_32x32x16_bf16(b1,qr[0],negm,0,0,0);}
    else{p0=__builtin_amdgcn_mfma_f32_32x32x16_bf16(b0,qr[d0],p0,0,0,0);p1=__builtin_amdgcn_mfma_f32_32x32x16_bf16(b1,qr[d0],p1,0,0,0);}}
}
typedef __attribute__((address_space(3))) const char* lds_cptr;
typedef short v4i16_t __attribute__((ext_vector_type(4)));
__device__ __forceinline__ void kload8(bf16x8*kf,lds_cptr kp){
  kf[0]=*(const __attribute__((address_space(3))) bf16x8*)(kp);      kf[1]=*(const __attribute__((address_space(3))) bf16x8*)(kp+512);
  kf[2]=*(const __attribute__((address_space(3))) bf16x8*)(kp+2048); kf[3]=*(const __attribute__((address_space(3))) bf16x8*)(kp+2560);
  kf[4]=*(const __attribute__((address_space(3))) bf16x8*)(kp+4096); kf[5]=*(const __attribute__((address_space(3))) bf16x8*)(kp+4608);
  kf[6]=*(const __attribute__((address_space(3))) bf16x8*)(kp+6144); kf[7]=*(const __attribute__((address_space(3))) bf16x8*)(kp+6656);
}
__device__ __forceinline__ void kload2(bf16x8*kf,lds_cptr kp,int j){ kf[2*j]=*(const __attribute__((address_space(3))) bf16x8*)(kp+j*2048); kf[2*j+1]=*(const __attribute__((address_space(3))) bf16x8*)(kp+j*2048+512); }
__device__ __forceinline__ s16x4 vtr(lds_cptr p){ return __builtin_bit_cast(s16x4,__builtin_amdgcn_ds_read_tr16_b64_v4i16((__attribute__((address_space(3))) v4i16_t*)p)); }
__device__ __forceinline__ float rowmax(const f32x16&p0,const f32x16&p1){
  float a=max3f(p0[0],p0[1],p1[0]),b=max3f(p0[2],p0[3],p1[1]);a=max3f(a,p1[2],p1[3]);
  #pragma unroll
  for(int r=4;r<16;r+=4){a=max3f(a,p0[r],p0[r+1]);b=max3f(b,p0[r+2],p0[r+3]);a=max3f(a,p1[r],p1[r+1]);b=max3f(b,p1[r+2],p1[r+3]);}
  const float m=max2f(a,b);
  auto rr=__builtin_amdgcn_permlane32_swap(__float_as_uint(m),__float_as_uint(m),false,false);
  return max2f(__uint_as_float(rr[0]),__uint_as_float(rr[1]));
}
__device__ __forceinline__ void pv(f32x16*o,int vb,bf16x8 pa0,bf16x8 pa1,bf16x8 pa2,bf16x8 pa3){
  #pragma unroll
  for(int d0=0;d0<2;++d0){s16x4 lo[4],hi[4];
    #pragma unroll
    for(int ks=0;ks<4;++ks){
      asm volatile("ds_read_b64_tr_b16 %0,%1 offset:%c2":"=&v"(lo[ks]):"v"(vb),"i"(d0*4096+ks*1024):"memory");
      asm volatile("ds_read_b64_tr_b16 %0,%1 offset:%c2":"=&v"(hi[ks]):"v"(vb),"i"(d0*4096+ks*1024+512):"memory");}
    asm volatile("s_waitcnt lgkmcnt(0)":::"memory");SBAR();
    #define PK(k) (bf16x8){lo[k][0],lo[k][1],lo[k][2],lo[k][3],hi[k][0],hi[k][1],hi[k][2],hi[k][3]}
    o[d0]=__builtin_amdgcn_mfma_f32_32x32x16_bf16(pa0,PK(0),o[d0],0,0,0);
    o[d0]=__builtin_amdgcn_mfma_f32_32x32x16_bf16(pa1,PK(1),o[d0],0,0,0);
    o[d0]=__builtin_amdgcn_mfma_f32_32x32x16_bf16(pa2,PK(2),o[d0],0,0,0);
    o[d0]=__builtin_amdgcn_mfma_f32_32x32x16_bf16(pa3,PK(3),o[d0],0,0,0);
    #undef PK
  }
}

#ifndef ATTN_STORE16
#define ATTN_STORE16(p,v) (*(u32x4*)(p)=(v))
#endif
template<int THRL,bool NEGM,class TM> __device__ __forceinline__ void attn_unit(const bf16*Qu,const int qp,const bf16*Kh,const bf16*Vh,const int kvp,bf16*Ou,const int op,const int NT,const TM&tm,const int tid,char*shm){
  const int lane=tid&63,r32=lane&31,hi=lane>>5; const int wid=__builtin_amdgcn_readfirstlane(tid>>6);
  const bf16*Qw=Qu+(long)(wid*QBLK)*qp;
  const unsigned lds0=(unsigned)(uintptr_t)shm;
  float*wsf=(float*)(shm+LDS_WS)+wid*64;
  const bf16*ksrc=Kh+(long)lane*kvp+wid*8;
  const bf16*vsrc=Vh+(long)(16*(wid&3)+(lane>>2))*kvp+(wid>>2)*32+(lane&3)*8;
  const unsigned kdst=lds0+LDS_K+wid*1024, vdst=lds0+LDS_V+wid*1024;
  #define DMA_K(t,slot) glds16(ksrc+(long)tm.row(t)*kvp,(unsigned)__builtin_amdgcn_readfirstlane(kdst+(slot)))
  #define DMA_V(t,slot) glds16(vsrc+(long)tm.row(t)*kvp,(unsigned)__builtin_amdgcn_readfirstlane(vdst+(slot)))
  const int vb0=(int)(lds0+LDS_V)+((lane>>4)&1)*32+(lane&3)*8+(4*hi+((lane&15)>>2))*64;
  const char*Kbase=shm+LDS_K; bf16x8 kf[8];
  const lds_cptr shm3=(lds_cptr)shm; const lds_cptr kp0=shm3+LDS_K+hi*1024+r32*16; const lds_cptr vp0=shm3+LDS_V+((lane>>4)&1)*32+(lane&3)*8+(4*hi+((lane&15)>>2))*64;
  DMA_K(0,0);DMA_V(0,0);DMA_K(1,SLOTB);
  bf16x8 qr[4];
  #pragma unroll
  for(int d0=0;d0<4;++d0)qr[d0]=*reinterpret_cast<const bf16x8*>(&Qw[(long)r32*qp+d0*16+hi*8]);
  float mhat=0.f,l_reg=0.f;f32x16 o[2];{float z_=0.f;asm volatile("":"+v"(z_));
  _Pragma("unroll") for(int r=0;r<16;++r){o[0][r]=z_;o[1][r]=z_;}}f32x16 negm=f32x16{};if(NEGM){float z_=0.f;asm volatile("":"+v"(z_));_Pragma("unroll") for(int r=0;r<16;++r)negm[r]=z_;asm volatile("":"+v"(negm));}
  #define CMASK(P0,P1,t) tm.mask(P0,P1,(t),wid,r32,hi)
  bool resc=false;
  #define START(P0,P1) do{ const float rm=rowmax(P0,P1); resc=false; \
    { const float dl=rm; mhat=fadd_s(mhat,dl); \
      _Pragma("unroll") for(int r=0;r<16;++r){P0[r]=fsub_s(P0[r],dl);P1[r]=fsub_s(P1[r],dl);} \
      if(NEGM){ _Pragma("unroll") for(int r=0;r<16;++r)negm[r]=-mhat; asm volatile("":"+v"(negm)); } } \
    _Pragma("unroll") for(int r=0;r<16;++r)P0[r]=__builtin_amdgcn_exp2f(P0[r]); }while(0)
  #define RESC() do{ if(resc){ asm volatile("s_waitcnt lgkmcnt(0)":::"memory"); \
      _Pragma("unroll") for(int d_=0;d_<2;++d_) _Pragma("unroll") for(int r=0;r<16;++r)o[d_][r]*=wsf[crow(r,hi)]; } }while(0)
  f32x16 pA0,pA1,pB0,pB1;
  int sl_prev=0,sl_cur=0,sl_next=SLOTB;
  #define ROT() do{sl_prev=sl_cur;sl_cur=sl_next;sl_next=(sl_next==(NSLOT-1)*SLOTB)?0:sl_next+SLOTB;}while(0)
  DMA_K(2,2*SLOTB);
  WAIT_BAR(3);
  qkt(pA0,pA1,Kbase,qr,negm,r32,hi);asm volatile("s_nop 15\n\ts_nop 7":"+v"(pA0),"+v"(pA1));CMASK(pA0,pA1,0);
  START(pA0,pA1);
  _Pragma("unroll") for(int r=0;r<16;++r)pA1[r]=__builtin_amdgcn_exp2f(pA1[r]);
  WAIT_BAR(0);
  DMA_K(3,0);DMA_V(1,SLOTB);
  ROT();
  kload8(kf,kp0+sl_cur);
  WAIT_BAR(2);
  s16x4 vlo[8],vhi[8]; u32x4 pw0,pw1,pw2,pw3;
  #define PKW(P,B) cvtpk_s(P[B],P[B+1])
  #define PAF(k) __builtin_bit_cast(bf16x8,pw##k)
  #define VFR(i) (bf16x8){vlo[i][0],vlo[i][1],vlo[i][2],vlo[i][3],vhi[i][0],vhi[i][1],vhi[i][2],vhi[i][3]}
  #define PIN(x) asm volatile("":"+v"(x))
  #define MX3(a,b,c) __builtin_fmaxf(__builtin_fmaxf((a),(b)),(c))
  #define GAPA(MF,A0,A1,A2,A3,W0,W1,PW) do{ MF; sacc+=A0; sacc+=A1; sacc+=A2; sacc+=A3; PIN(sacc); W0; W1; PIN(PW); SBAR(); }while(0)
  #define EX(v) __builtin_amdgcn_exp2f(v)
  #define GAPB(MF,X,B) do{ MF; X[B]=EX(X[B]); X[B+1]=EX(X[B+1]); X[B+2]=EX(X[B+2]); X[B+3]=EX(X[B+3]); PIN(X); SBAR(); }while(0)
  #define VRD(i) do{ vlo[i]=vtr(vp_+(((i)>>2)*4096+((i)&3)*1024)); vhi[i]=vtr(vp_+(((i)>>2)*4096+((i)&3)*1024+512)); }while(0)
  #define KRD(G,j) do{ if(G){ kload2(kf,kp0+sl_next,j); SBAR(); } }while(0)
  #define STEP(C0,C1,P0,P1,t,GK,GV,GL) do{ SBAR(); \
    const lds_cptr vp_=vp0+sl_prev; \
    VRD(0); SBAR(); float sacc=(P0[0]+P0[1]); \
    GAPA(C0=__builtin_amdgcn_mfma_f32_32x32x16_bf16(kf[0],qr[0],negm,0,0,0), P0[2],P0[3],P0[4],P0[5],     pw0[0]=PKW(P0,0), pw0[1]=PKW(P0,2), pw0); \
    VRD(4); SBAR(); GAPA(C1=__builtin_amdgcn_mfma_f32_32x32x16_bf16(kf[1],qr[0],negm,0,0,0), P0[6],P0[7],P0[8],P0[9],     pw0[2]=PKW(P0,4), pw0[3]=PKW(P0,6), pw0); \
    VRD(1); SBAR(); GAPA(C0=__builtin_amdgcn_mfma_f32_32x32x16_bf16(kf[2],qr[1],C0,0,0,0),   P0[10],P0[11],P0[12],P0[13], pw1[0]=PKW(P0,8), pw1[1]=PKW(P0,10), pw1); \
    VRD(5); SBAR(); GAPA(C1=__builtin_amdgcn_mfma_f32_32x32x16_bf16(kf[3],qr[1],C1,0,0,0),   P0[14],P0[15],P1[0],P1[1],   pw1[2]=PKW(P0,12),pw1[3]=PKW(P0,14), pw1); \
    VRD(2); SBAR(); GAPA(C0=__builtin_amdgcn_mfma_f32_32x32x16_bf16(kf[4],qr[2],C0,0,0,0),   P1[2],P1[3],P1[4],P1[5],     pw2[0]=PKW(P1,0), pw2[1]=PKW(P1,2), pw2); \
    VRD(6); SBAR(); GAPA(C1=__builtin_amdgcn_mfma_f32_32x32x16_bf16(kf[5],qr[2],C1,0,0,0),   P1[6],P1[7],P1[8],P1[9],     pw2[2]=PKW(P1,4), pw2[3]=PKW(P1,6), pw2); \
    VRD(3); SBAR(); GAPA(C0=__builtin_amdgcn_mfma_f32_32x32x16_bf16(kf[6],qr[3],C0,0,0,0),   P1[10],P1[11],P1[12],P1[13], pw3[0]=PKW(P1,8), pw3[1]=PKW(P1,10), pw3); \
    VRD(7); SBAR(); GAPA(C1=__builtin_amdgcn_mfma_f32_32x32x16_bf16(kf[7],qr[3],C1,0,0,0),   P1[14],P1[15],0.f,0.f,       pw3[2]=PKW(P1,12),pw3[3]=PKW(P1,14), pw3); \
    l_reg+=sacc; \
    if(GK){DMA_K((t)+3,sl_cur);} if(GV){DMA_V((t)+1,sl_next);} \
    if(!NEGM){ _Pragma("unroll") for(int r=0;r<16;++r){C0[r]-=mhat;C1[r]-=mhat;} } \
    CMASK(C0,C1,t); \
    { float a=MX3(C0[0],C0[1],C1[0]),b=MX3(C0[2],C0[3],C1[1]); a=MX3(a,C1[2],C1[3]); \
      _Pragma("unroll") for(int r=4;r<16;r+=4){a=MX3(a,C0[r],C0[r+1]);b=MX3(b,C0[r+2],C0[r+3]);a=MX3(a,C1[r],C1[r+1]);b=MX3(b,C1[r+2],C1[r+3]);} \
      float rm=__builtin_fmaxf(a,b); { auto rr=__builtin_amdgcn_permlane32_swap(__float_as_uint(rm),__float_as_uint(rm),false,false); rm=__builtin_fmaxf(__uint_as_float(rr[0]),__uint_as_float(rr[1])); } \
      resc=false; \
      if(__builtin_expect(__any(rm>(float)THRL),0)){ const float dl=__builtin_fmaxf(rm,0.f); mhat+=dl; \
        _Pragma("unroll") for(int r=0;r<16;++r){C0[r]-=dl;C1[r]-=dl;} \
        if(NEGM){ _Pragma("unroll") for(int r=0;r<16;++r)negm[r]=-mhat; asm volatile("":"+v"(negm)); } \
        const float f=__builtin_amdgcn_exp2f(-dl); l_reg*=f; if(hi==0)wsf[r32]=f; resc=true; } } \
    SBAR(); \
    GAPB(o[0]=__builtin_amdgcn_mfma_f32_32x32x16_bf16(PAF(0),VFR(0),o[0],0,0,0), C0,0); \
    GAPB(o[1]=__builtin_amdgcn_mfma_f32_32x32x16_bf16(PAF(0),VFR(4),o[1],0,0,0), C0,4); \
    KRD(GL,0); GAPB(o[0]=__builtin_amdgcn_mfma_f32_32x32x16_bf16(PAF(1),VFR(1),o[0],0,0,0), C0,8); \
    KRD(GL,1); GAPB(o[1]=__builtin_amdgcn_mfma_f32_32x32x16_bf16(PAF(1),VFR(5),o[1],0,0,0), C0,12); \
    KRD(GL,2); GAPB(o[0]=__builtin_amdgcn_mfma_f32_32x32x16_bf16(PAF(2),VFR(2),o[0],0,0,0), C1,0); \
    KRD(GL,3); GAPB(o[1]=__builtin_amdgcn_mfma_f32_32x32x16_bf16(PAF(2),VFR(6),o[1],0,0,0), C1,4); \
    GAPB(o[0]=__builtin_amdgcn_mfma_f32_32x32x16_bf16(PAF(3),VFR(3),o[0],0,0,0), C1,8); \
    GAPB(o[1]=__builtin_amdgcn_mfma_f32_32x32x16_bf16(PAF(3),VFR(7),o[1],0,0,0), C1,12); \
    }while(0)
  int t=1;
  for(;t+5<NT;t+=2){
    STEP(pB0,pB1,pA0,pA1,t,true,true,true);     WAIT_BAR(2); RESC(); ROT();
    STEP(pA0,pA1,pB0,pB1,t+1,true,true,true);   WAIT_BAR(2); RESC(); ROT();
  }
  #define ENDW(tt) do{ if((tt)+3<NT){WAIT_BAR(2);} else if((tt)+2<NT){WAIT_BAR(1);} else {WAIT_BAR(0);} }while(0)
  for(;t+1<NT;t+=2){
    STEP(pB0,pB1,pA0,pA1,t,(t+3<NT),(t+1<NT),(t+1<NT));       ENDW(t);   RESC(); ROT();
    STEP(pA0,pA1,pB0,pB1,t+1,(t+4<NT),(t+2<NT),(t+2<NT));     ENDW(t+1); RESC(); ROT();
  }
  STEP(pB0,pB1,pA0,pA1,NT-1,false,false,false); RESC();
  { float sacc=pB0[0]+pB0[1]; _Pragma("unroll") for(int r=2;r<16;++r)sacc+=pB0[r]; _Pragma("unroll") for(int r=0;r<16;++r)sacc+=pB1[r]; l_reg+=sacc;
    pw0=(u32x4){PKW(pB0,0),PKW(pB0,2),PKW(pB0,4),PKW(pB0,6)};pw1=(u32x4){PKW(pB0,8),PKW(pB0,10),PKW(pB0,12),PKW(pB0,14)};pw2=(u32x4){PKW(pB1,0),PKW(pB1,2),PKW(pB1,4),PKW(pB1,6)};pw3=(u32x4){PKW(pB1,8),PKW(pB1,10),PKW(pB1,12),PKW(pB1,14)};
    SBAR(); pv(o,vb0+sl_cur,PAF(0),PAF(1),PAF(2),PAF(3)); }
  #undef PKW
  #undef PAF
  #undef VFR
  #undef PIN
  #undef MX3
  #undef GAPA
  #undef GAPB
  #undef EX
  #undef VRD
  #undef KRD
  #undef STEP
  #undef ENDW
  {auto rr=__builtin_amdgcn_permlane32_swap(__float_as_uint(l_reg),__float_as_uint(l_reg),false,false);l_reg=__uint_as_float(rr[0])+__uint_as_float(rr[1]);}
  if(hi==0)wsf[32+r32]=l_reg;asm volatile("s_waitcnt lgkmcnt(0)":::"memory");
  float rli[16];
  #pragma unroll
  for(int r=0;r<16;++r)rli[r]=__builtin_amdgcn_rcpf(wsf[32+crow(r,hi)]);
  bf16*Ow=Ou+(long)(wid*QBLK)*op;
  { bf16*stg=(bf16*)(shm+LDS_OST)+wid*2048;
    #pragma unroll
    for(int r=0;r<16;++r){const int orow=crow(r,hi);
      #pragma unroll
      for(int d0=0;d0<2;++d0)stg[orow*64+d0*32+r32]=__float2bfloat16(o[d0][r]*rli[r]);}
    asm volatile("s_waitcnt lgkmcnt(0)":::"memory");
    #pragma unroll
    for(int i=0;i<4;++i){const int row=i*8+(lane>>3),ch=lane&7; const u32x4 v=*(const u32x4*)(stg+row*64+ch*8); ATTN_STORE16(Ow+(long)row*op+ch*8,v);} }
  asm volatile("s_waitcnt lgkmcnt(0)\n\ts_barrier":::"memory");
  #undef DMA_K
  #undef DMA_V
  #undef CMASK
  #undef START
  #undef RESC
  #undef ROT
}
constexpr int ATTN_LDS_BYTES=LDS_BYTES;
#undef SBAR
#undef WAIT_BAR
}

struct OnlineSm { float q[64], o[64], m, l; };
DEV void osm_init(OnlineSm& S, const bf16_t* qp, float scale) {
    load64(qp, S.q);
#pragma unroll
    for (int d = 0; d < 64; ++d) { S.q[d] *= scale; S.o[d] = 0.f; }
    S.m = -1e30f; S.l = 0.f;
}
DEV void osm_key(OnlineSm& S, const bf16_t* kp, const bf16_t* vp, float bias) {
    float s = bias;
#pragma unroll
    for (int c = 0; c < 8; ++c) { float kf[8]; unpack8(((const bf16x8*)kp)[c], kf);
#pragma unroll
        for (int j = 0; j < 8; ++j) s += S.q[8 * c + j] * kf[j]; }
    if (s > S.m) { const float sc = __expf(S.m - s); S.l *= sc;
#pragma unroll
        for (int d = 0; d < 64; ++d) S.o[d] *= sc;
        S.m = s; }
    const float p = __expf(s - S.m); S.l += p;
#pragma unroll
    for (int c = 0; c < 8; ++c) { float vf[8]; unpack8(((const bf16x8*)vp)[c], vf);
#pragma unroll
        for (int j = 0; j < 8; ++j) S.o[8 * c + j] += p * vf[j]; }
}
DEV void osm_store(OnlineSm& S, bf16_t* op) {
    const float rl = 1.f / S.l;
#pragma unroll
    for (int d = 0; d < 64; ++d) S.o[d] *= rl;
    store64(op, S.o);
}

struct TMDense {
    DEV int row(int t) const { return t < 4 ? SEQ + 64 * t : 64 * (t - 4); }
    DEV void mask(attn_body::f32x16&, attn_body::f32x16&, int, int, int, int) const {}
};
DEV void phase_mix_even(KArgsP a, const Fr& F, int i) {
    const bf16_t* P = (const bf16_t*)(a->ws + WS_P); bf16_t* MX = (bf16_t*)(a->ws + WS_MX);
    { typedef attn_body::bf16 abf; const int vcu = (F.G % 8 == 0) ? (F.bid % 8) * (F.G / 8) + F.bid / 8 : F.bid;
      for (int k = 0;; ++k) {
          int u; if (F.G == 256) u = k < 2 ? 2 * vcu + k : ((k == 2 && vcu < 8) ? 512 + vcu : -1); else u = (k * F.G + vcu < 520) ? k * F.G + vcu : -1;
          if (u < 0) break;
          int h, row0, NT; if (u < 512) { h = (u >> 8) * 4 + ((u & 255) >> 6); row0 = (u & 63) * 256; NT = NTOK / 64; } else { h = u - 512; row0 = SEQ; NT = NCTX / 64; }
          const int kvh = h >> 2;
          attn_body::attn_unit<8, true>((const abf*)P + (size_t)row0 * EV_IN + h * 64, EV_IN, (const abf*)P + 512 + kvh * 64, (const abf*)P + 640 + kvh * 64, EV_IN,
                                  (abf*)MX + (size_t)row0 * DM + h * 64, DM, NT, TMDense{}, F.tid, (char*)F.lds);
      } }
}
DEV void phase_mix_even_b(KArgsP a, const Fr& F, int i) {
    const bf16_t* P = (const bf16_t*)(a->ws + WS_P); bf16_t* MX = (bf16_t*)(a->ws + WS_MX);
    const bf16_t* BW = (const bf16_t*)(a->ws + WS_BWS) + (size_t)i * 8 * 128 * 128; const float* BB = a->in[I_BBS] + i * 8 * 128; const float* GN = a->in[I_BVN] + i * 512;
    LAS bf16_t* vt = (LAS bf16_t*)F.lds;
    constexpr int VTP = 136;
    const int r32 = F.lane & 31, hi = F.lane >> 5, t0 = (F.wave >> 1) * 32, c0 = (F.wave & 1) * 32;
    for (int it = F.bid; it < (NTOK / 128) * 8; it += F.G) {
        const int n = it >> 3, g = it & 7;
        __syncthreads();
#pragma unroll
        for (int k = 0; k < 2; ++k) { const int idx = F.tid + k * NTHR, sidx = idx >> 3, j8 = idx & 7;
            float x[8]; unpack8(*(const bf16x8*)(P + (size_t)(n * 128 + sidx) * EV_IN + 1280 + g * 64 + 8 * j8), x);
            float ss = 0.f;
#pragma unroll
            for (int d = 0; d < 8; ++d) { x[d] = gelu_tanh(x[d]); ss += x[d] * x[d]; }
            ss = sum8lanes(ss); const float r = rsqrtf(ss * (1.f / 64.f) + EPS);
#pragma unroll
            for (int d = 0; d < 8; ++d) vt[(8 * j8 + d) * VTP + sidx] = (bf16_t)f2bf(x[d] * r * GN[g * 64 + 8 * j8 + d]); }
        __syncthreads();
        f32x16 acc; { float z_ = 0.f; asm volatile("" : "+v"(z_));
#pragma unroll
            for (int q = 0; q < 16; ++q) acc[q] = z_; }
        const bf16_t* wp = BW + (size_t)g * 128 * 128 + (size_t)(t0 + r32) * 128 + 8 * hi;
        const LAS bf16_t* bp = vt + (c0 + r32) * VTP + 8 * hi;
#pragma unroll
        for (int ks = 0; ks < 8; ++ks) acc = __builtin_amdgcn_mfma_f32_32x32x16_bf16(*(const bf16x8*)(wp + 16 * ks), *(const LAS bf16x8*)(bp + 16 * ks), acc, 0, 0, 0);
#pragma unroll
        for (int q = 0; q < 16; ++q) { const int t = t0 + (q & 3) + 8 * (q >> 2) + 4 * hi, row = n * 128 + t, c = c0 + r32;
            const float u = gelu_tanh(bf2f(P[(size_t)row * EV_IN + 768 + g * 64 + c]));
            MX[(size_t)row * DM + 512 + g * 64 + c] = (bf16_t)f2bf(u * (acc[q] + BB[g * 128 + t])); }
    }
}

constexpr int NA_BIAS_OFF = 90112;
struct TMNA {
    int r4, lo; const LAS float* bt;
    DEV int row(int t) const { if (t < 4) return SEQ + 64 * t; int kr = lo + t - 4; kr = kr > 255 ? 255 : kr; return kr * GRIDW; }
    DEV void mask(attn_body::f32x16& p0, attn_body::f32x16& p1, int t, int wid, int r32, int hi) const {
        if (t < 4) return;
        float ninf = -INFINITY; asm volatile("" : "+v"(r32), "+v"(hi), "+v"(ninf));
        const int kr = lo + t - 4, r = r4 + (wid >> 1); int rs = r - 4; rs = rs < 0 ? 0 : (rs > 248 ? 248 : rs);
        if (kr < rs || kr > rs + 7) {
#pragma unroll
            for (int q = 0; q < 16; ++q) { p0[q] = ninf; p1[q] = ninf; }
            return; }
        const int c = 32 * (wid & 1) + r32; int cs = c - 8; cs = cs < 0 ? 0 : (cs > 48 ? 48 : cs);
        const LAS float* bp = bt + (kr - r + 7) * 31;
#pragma unroll
        for (int q = 0; q < 16; ++q) { const int kc = (q & 3) + 8 * (q >> 2) + 4 * hi;
            int i0 = kc - c + 15; i0 = i0 < 0 ? 0 : (i0 > 30 ? 30 : i0); int i1 = kc + 32 - c + 15; i1 = i1 < 0 ? 0 : (i1 > 30 ? 30 : i1);
            const float b0 = bp[i0], b1 = bp[i1];
            p0[q] = ((unsigned)(kc - cs) <= 15u) ? p0[q] + b0 : ninf;
            p1[q] = ((unsigned)(kc + 32 - cs) <= 15u) ? p1[q] + b1 : ninf; }
    }
};
DEV void phase_mix_odd(KArgsP a, const Fr& F, int i) {
    const bf16_t* P = (const bf16_t*)(a->ws + WS_P); bf16_t* MX = (bf16_t*)(a->ws + WS_MX);
    const float* rpb = a->in[I_RPB] + (size_t)i * 8 * 15 * 31;
    { typedef attn_body::bf16 abf; const int vcu = (F.G % 8 == 0) ? (F.bid % 8) * (F.G / 8) + F.bid / 8 : F.bid;
      LAS float* bt = (LAS float*)(F.lds + NA_BIAS_OFF);
      for (int e = F.tid; e < 8 * 15 * 31; e += NTHR) bt[e] = rpb[e] * 1.4426950408889634f;
      __syncthreads();
      for (int k = 0;; ++k) {
          int u; if (F.G == 256) u = k < 2 ? 2 * vcu + k : ((k == 2 && vcu < 8) ? 512 + vcu : -1); else u = (k * F.G + vcu < 520) ? k * F.G + vcu : -1;
          if (u < 0) break;
          if (u < 512) { const int h = u >> 6, r4 = (u & 63) * 4;
              int lo = r4 - 4; lo = lo < 0 ? 0 : (lo > 248 ? 248 : lo); int hi = r4 - 1; hi = hi < 0 ? 0 : (hi > 248 ? 248 : hi); hi += 7;
              const int nloc = (hi - lo + 2) & ~1;
              TMNA tm{r4, lo, bt + h * 465};
              attn_body::attn_unit<8, true>((const abf*)P + (size_t)(r4 * GRIDW) * OD_IN + h * 64, OD_IN, (const abf*)P + 512 + h * 64, (const abf*)P + 1024 + h * 64, OD_IN,
                                      (abf*)MX + (size_t)(r4 * GRIDW) * DM + h * 64, DM, 4 + nloc, tm, F.tid, (char*)F.lds);
          } else { const int h = u - 512;
              attn_body::attn_unit<8, true>((const abf*)P + (size_t)SEQ * OD_IN + h * 64, OD_IN, (const abf*)P + 512 + h * 64, (const abf*)P + 1024 + h * 64, OD_IN,
                                      (abf*)MX + (size_t)SEQ * DM + h * 64, DM, NCTX / 64, TMDense{}, F.tid, (char*)F.lds); }
      } }
}
DEV void phase_mix_odd_b(KArgsP a, const Fr& F, int i) {
    const bf16_t* P = (const bf16_t*)(a->ws + WS_P); bf16_t* MX = (bf16_t*)(a->ws + WS_MX);
    const float* DW = a->in[I_DDW] + (size_t)i * 31 * 512; const float* DB = a->in[I_DDWB] + i * 512;
    const float* LG = a->in[I_DLNG] + i * 512; const float* LB = a->in[I_DLNB] + i * 512;
    for (int row = F.gw; row < NTOK; row += F.NGW) {
        const int lo = row < SEQ ? 0 : SEQ, hi = row < SEQ ? SEQ : NTOK, ch = 8 * F.lane;
        float acc[8];
#pragma unroll
        for (int j = 0; j < 8; ++j) acc[j] = DB[ch + j];
        for (int w = 0; w < 31; ++w) { const int tt = row + w - 15; if (tt < lo || tt >= hi) continue;
            float y[8]; unpack8(*(const bf16x8*)(P + (size_t)tt * OD_IN + 1536 + ch), y);
            const f32x4 w0 = *(const f32x4*)(DW + w * 512 + ch), w1 = *(const f32x4*)(DW + w * 512 + ch + 4);
            acc[0] += y[0] * w0.x; acc[1] += y[1] * w0.y; acc[2] += y[2] * w0.z; acc[3] += y[3] * w0.w; acc[4] += y[4] * w1.x; acc[5] += y[5] * w1.y; acc[6] += y[6] * w1.z; acc[7] += y[7] * w1.w; }
        float s = 0.f;
#pragma unroll
        for (int j = 0; j < 8; ++j) s += acc[j];
        const float mean = wave_sum(s) * (1.f / 512.f); float q = 0.f;
#pragma unroll
        for (int j = 0; j < 8; ++j) { acc[j] -= mean; q += acc[j] * acc[j]; }
        const float rstd = rsqrtf(wave_sum(q) * (1.f / 512.f) + EPS);
#pragma unroll
        for (int j = 0; j < 8; ++j) acc[j] = siluf_(acc[j] * rstd * LG[ch + j] + LB[ch + j]);
        *(u32x4*)(MX + (size_t)row * DM + 512 + ch) = pack8(acc);
    }
}

DEV float reduce16_t(const float (&v)[16], int lane) {
    float a8[8], a4[4], a2[2];
    const bool b5 = (lane & 32) != 0, b4 = (lane & 16) != 0, b3 = (lane & 8) != 0, b2 = (lane & 4) != 0;
#pragma unroll
    for (int e = 0; e < 8; ++e) { const float keep = b5 ? v[e + 8] : v[e], send = b5 ? v[e] : v[e + 8]; a8[e] = keep + shx<32>(send); }
#pragma unroll
    for (int e = 0; e < 4; ++e) { const float keep = b4 ? a8[e + 4] : a8[e], send = b4 ? a8[e] : a8[e + 4]; a4[e] = keep + shx<16>(send); }
#pragma unroll
    for (int e = 0; e < 2; ++e) { const float keep = b3 ? a4[e + 2] : a4[e], send = b3 ? a4[e] : a4[e + 2]; a2[e] = keep + shx<8>(send); }
    float r; { const float keep = b2 ? a2[1] : a2[0], send = b2 ? a2[0] : a2[1]; r = keep + shx<4>(send); }
    r += shx<1>(r); r += shx<2>(r);
    return r;
}
struct Route { int e0, e1; float w0, w1; };
DEV Route route_token(float affv, float selv) {
    float aff[16], sel[16];
#pragma unroll
    for (int e = 0; e < 16; ++e) { aff[e] = __builtin_bit_cast(float, __builtin_amdgcn_readlane(__builtin_bit_cast(int, affv), 4 * e)); sel[e] = __builtin_bit_cast(float, __builtin_amdgcn_readlane(__builtin_bit_cast(int, selv), 4 * e));
        asm volatile("" : "+v"(aff[e]), "+v"(sel[e])); }
    int bg = 0; float bgs = 0.f;
#pragma unroll
    for (int gq = 0; gq < 4; ++gq) { const float x0 = sel[4 * gq], x1 = sel[4 * gq + 1], x2 = sel[4 * gq + 2], x3 = sel[4 * gq + 3];
        const float h1 = fmaxf(x0, x1), l1 = fminf(x0, x1), h2 = fmaxf(x2, x3), l2 = fminf(x2, x3);
        const float gs = fmaxf(h1, h2) + fmaxf(fminf(h1, h2), fmaxf(l1, l2));
        const bool better = gq == 0 || gs > bgs; bg = better ? gq : bg; bgs = better ? gs : bgs; }
    float sg[4], ag[4];
#pragma unroll
    for (int k = 0; k < 4; ++k) { sg[k] = bg == 0 ? sel[k] : (bg == 1 ? sel[4 + k] : (bg == 2 ? sel[8 + k] : sel[12 + k])); ag[k] = bg == 0 ? aff[k] : (bg == 1 ? aff[4 + k] : (bg == 2 ? aff[8 + k] : aff[12 + k])); }
    int i0 = 0; float v0 = sg[0], a0 = ag[0];
#pragma unroll
    for (int k = 1; k < 4; ++k) { const bool b = sg[k] > v0; i0 = b ? k : i0; v0 = b ? sg[k] : v0; a0 = b ? ag[k] : a0; }
    int i1 = -1; float v1 = 0.f, a1 = 0.f;
#pragma unroll
    for (int k = 0; k < 4; ++k) { const bool b = (k != i0) && (i1 < 0 || sg[k] > v1); i1 = b ? k : i1; v1 = b ? sg[k] : v1; a1 = b ? ag[k] : a1; }
    Route R; R.e0 = 4 * bg + i0; R.e1 = 4 * bg + i1; const float inv = 1.f / (a0 + a1); R.w0 = a0 * inv; R.w1 = a1 * inv; return R;
}
DEV void phase_norm2(KArgsP a, const Fr& F, int l) {
    const int ntok = l < DEPTH - 1 ? NTOK : SEQ, rpw = (ntok + F.G - 1) / F.G;
    LAS float* rwt = (LAS float*)F.lds;
    LAS int* le = (LAS int*)(F.lds + 65536);
    { const f32x4* src = (const f32x4*)(a->ws + WS_RWT); for (int e = F.tid; e < 4096; e += NTHR) ((LAS f32x4*)rwt)[e] = src[e]; }
    __syncthreads();
    bf16_t* H = (bf16_t*)(a->ws + WS_H); TokInfo* TI = (TokInfo*)(a->ws + WS_TOK);
    const int r0 = F.bid * rpw, r1 = (r0 + rpw < ntok) ? r0 + rpw : ntok;
    const float rbias = a->in[I_RB][(F.lane >> 2) & 15];
    f32x4 vn[4];
    { const float* xr = xrow_out(a, r0 + F.wave < r1 ? r0 + F.wave : r0);
#pragma unroll
      for (int j = 0; j < 4; ++j) vn[j] = ((const f32x4*)xr)[64 * j + F.lane]; }
    f32x4 MA[4], MB[4]; int mtype = -1;
    for (int row = r0 + F.wave; row < r1; row += NWAVES) {
        f32x4 v[4]; float ss = 0.f;
#pragma unroll
        for (int j = 0; j < 4; ++j) { v[j] = vn[j]; ss += (v[j].x * v[j].x + v[j].y * v[j].y) + (v[j].z * v[j].z + v[j].w * v[j].w); }
        { const float* xr = xrow_out(a, row + NWAVES < r1 ? row + NWAVES : row);
#pragma unroll
          for (int j = 0; j < 4; ++j) vn[j] = ((const f32x4*)xr)[64 * j + F.lane]; }
        const int ty = row < SEQ ? 0 : 1;
        if (ty != mtype) { mtype = ty; const float* g = a->in[I_N2G] + l * DM; const float* sc = modp(a, l, row, 4); const float* sh = modp(a, l, row, 3);
#pragma unroll
            for (int j = 0; j < 4; ++j) { const int c4 = 64 * j + F.lane; MA[j] = ((const f32x4*)g)[c4] * (((const f32x4*)sc)[c4] + 1.f); MB[j] = ((const f32x4*)sh)[c4]; } }
        const float rstd = rsqrtf(wave_sum(ss) * (1.f / DM) + EPS);
        float lg[16];
#pragma unroll
        for (int e = 0; e < 16; ++e) lg[e] = 0.f;
#pragma unroll
        for (int j = 0; j < 4; ++j) { const int c4 = 64 * j + F.lane;
            const f32x4 o = v[j] * rstd * MA[j] + MB[j];
            { u32x2 w; w.x = pk2(o.x, o.y); w.y = pk2(o.z, o.w); ((u32x2*)(H + (size_t)row * DM))[c4] = w; }
#pragma unroll
            for (int e = 0; e < 16; ++e) { const f32x4 rw = *(const LAS f32x4*)(rwt + e * 1024 + 4 * c4); lg[e] += (o.x * rw.x + o.y * rw.y) + (o.z * rw.z + o.w * rw.w); }
            __builtin_amdgcn_sched_barrier(0); }
        const float af = sigmoidf_(reduce16_t(lg, F.lane));
        const Route R = route_token(af, af + rbias);
        if (F.lane == 0) { TI[row].e0 = R.e0; TI[row].e1 = R.e1; TI[row].w0 = R.w0; TI[row].w1 = R.w1; le[row - r0] = R.e0; le[rpw + row - r0] = R.e1; }
    }
    __syncthreads();
    const int tid2 = F.wave * 64 + lane_id_fresh();
    if (tid2 < 16) { const int e = tid2; int cnt = 0;
        for (int j = 0; j < r1 - r0; ++j) { if (le[j] == e) TI[r0 + j].r0 = cnt++; else if (le[rpw + j] == e) TI[r0 + j].r1 = cnt++; }
        ((int*)(a->ws + WS_CNT))[F.bid * 16 + e] = cnt; }
}

DEV void phase_gather(KArgsP a, const Fr& F, int l) {
    const int ntok = l < DEPTH - 1 ? NTOK : SEQ, rpw = (ntok + F.G - 1) / F.G;
    LAS int* sb = (LAS int*)F.lds;
    const int* cnt = (const int*)(a->ws + WS_CNT);
    if (F.tid < 48) sb[F.tid] = 0;
    __syncthreads();
    { const int e = F.tid & 15; int base = 0, tot = 0;
      for (int w = F.tid >> 4; w < F.G; w += NTHR / 16) { const int c = cnt[w * 16 + e]; base += (w < F.bid) ? c : 0; tot += c; }
      atomicAdd((int*)(sb + e), base); atomicAdd((int*)(sb + 16 + e), tot); }
    __syncthreads();
    if (F.tid < 16) { int ps = 0;
#pragma unroll
        for (int e = 0; e < 16; ++e) { const int pc = (sb[16 + e] + 255) & ~255; if (e < F.tid) ps += pc; }
        sb[32 + F.tid] = ps; }
    __syncthreads();
    if (F.bid == 0 && F.tid <= MAXBLK) { int* blk = (int*)(a->ws + WS_BLK); const int b = F.tid - 1;
        const int pend15 = sb[32 + 15] + ((sb[16 + 15] + 255) & ~255);
        if (F.tid == 0) blk[0] = pend15 >> 8;
        else if (b * 256 < pend15) { int e = 0;
#pragma unroll
            for (int q = 1; q < 16; ++q) e += (sb[32 + q] <= b * 256) ? 1 : 0;
            blk[1 + b] = e; } }
    const bf16_t* H = (const bf16_t*)(a->ws + WS_H); bf16_t* BUF = (bf16_t*)(a->ws + WS_BUF); TokInfo* TI = (TokInfo*)(a->ws + WS_TOK);
    const int r0 = F.bid * rpw, r1 = (r0 + rpw < ntok) ? r0 + rpw : ntok;
    for (int row = r0 + F.wave; row < r1; row += NWAVES) {
        const TokInfo ti = TI[row];
        const int d0 = sb[32 + ti.e0] + sb[ti.e0] + ti.r0, d1 = sb[32 + ti.e1] + sb[ti.e1] + ti.r1;
        if (F.lane == 0) { TI[row].d0 = d0; TI[row].d1 = d1; }
        const u32x4* src = (const u32x4*)(H + (size_t)row * DM); const u32x4 v0 = src[F.lane], v1 = src[64 + F.lane];
        u32x4* q0 = (u32x4*)(BUF + (size_t)d0 * DM); u32x4* q1 = (u32x4*)(BUF + (size_t)d1 * DM);
        q0[F.lane] = v0; q0[64 + F.lane] = v1; q1[F.lane] = v0; q1[64 + F.lane] = v1;
    }
}

DEV void phase_gu_simple(KArgsP a, const Fr& F, int l) {
    const int* blk = (const int*)(a->ws + WS_BLK); const int nblk = blk[0];
    const bf16_t* BUF = (const bf16_t*)(a->ws + WS_BUF); bf16_t* ACT = (bf16_t*)(a->ws + WS_ACT);
    const int r32 = F.lane & 31, hi = F.lane >> 5;
    for (int t = F.gw; t < nblk * 128; t += F.NGW) {
        const int b = t >> 7, q = t & 127, mt = q >> 4, ct = q & 15, e = blk[1 + b];
        const bf16_t* W = (const bf16_t*)(a->ws + WS_WGU) + (size_t)(l * 16 + e) * 1024 * 1024;
        const int m0 = b * 256 + mt * 32, c0 = ct * 32, ng = 256 * (c0 / 128) + (c0 % 128);
        f32x16 ag = {}, au = {};
        const bf16_t* ap = BUF + (size_t)(m0 + r32) * DM + 8 * hi; const bf16_t* gp = W + (size_t)(ng + r32) * DM + 8 * hi; const bf16_t* up = gp + (size_t)128 * DM;
        for (int k = 0; k < DM; k += 16) { const bf16x8 av = *(const bf16x8*)(ap + k);
            ag = __builtin_amdgcn_mfma_f32_32x32x16_bf16(av, *(const bf16x8*)(gp + k), ag, 0, 0, 0); au = __builtin_amdgcn_mfma_f32_32x32x16_bf16(av, *(const bf16x8*)(up + k), au, 0, 0, 0); }
#pragma unroll
        for (int r = 0; r < 16; ++r) { const int row = m0 + (r & 3) + 8 * (r >> 2) + 4 * hi; ACT[(size_t)row * DEXP + c0 + r32] = (bf16_t)f2bf(siluf_(ag[r]) * au[r]); }
    }
}
DEV void phase_down_simple(KArgsP a, const Fr& F, int l) {
    const int* blk = (const int*)(a->ws + WS_BLK); const int nblk = blk[0];
    const bf16_t* ACT = (const bf16_t*)(a->ws + WS_ACT); bf16_t* Y = (bf16_t*)(a->ws + WS_P);
    const int r32 = F.lane & 31, hi = F.lane >> 5;
    for (int t = F.gw; t < nblk * 256; t += F.NGW) {
        const int b = t >> 8, q = t & 255, mt = q >> 5, nt = q & 31, e = blk[1 + b];
        const bf16_t* W = (const bf16_t*)(a->ws + WS_WDN) + (size_t)(l * 16 + e) * 1024 * 512;
        const int m0 = b * 256 + mt * 32, n0 = nt * 32; f32x16 acc = {};
        const bf16_t* ap = ACT + (size_t)(m0 + r32) * DEXP + 8 * hi; const bf16_t* bp = W + (size_t)(n0 + r32) * DEXP + 8 * hi;
        for (int k = 0; k < DEXP; k += 16) acc = __builtin_amdgcn_mfma_f32_32x32x16_bf16(*(const bf16x8*)(ap + k), *(const bf16x8*)(bp + k), acc, 0, 0, 0);
#pragma unroll
        for (int r = 0; r < 16; ++r) { const int row = m0 + (r & 3) + 8 * (r >> 2) + 4 * hi; Y[(size_t)row * DM + n0 + r32] = (bf16_t)f2bf(acc[r]); }
    }
}

DEV void comb_load(KArgsP a, int row, const bf16_t* Y, const TokInfo* TI, TokInfo& ti, f32x4 (&x)[4], u32x2 (&p0)[4], u32x2 (&p1)[4], int lane) {
    ti = TI[row]; const float* xr = xrow_out(a, row);
    const u32x2* y0 = (const u32x2*)(Y + (size_t)ti.d0 * DM); const u32x2* y1 = (const u32x2*)(Y + (size_t)ti.d1 * DM);
#pragma unroll
    for (int j = 0; j < 4; ++j) { const int c4 = 64 * j + lane; x[j] = ((const f32x4*)xr)[c4]; p0[j] = y0[c4]; p1[j] = y1[c4]; }
}
DEV void comb_finish(KArgsP a, int l, int row, const TokInfo& ti, f32x4 (&x)[4], const u32x2 (&p0)[4], const u32x2 (&p1)[4], bf16_t* H, int lane) {
    float* xr = xrow_out(a, row); const float* g2 = modp(a, l, row, 5);
#pragma unroll
    for (int j = 0; j < 4; ++j) { const int c4 = 64 * j + lane; const f32x4 G = ((const f32x4*)g2)[c4];
        f32x4 f; f.x = ti.w0 * __uint_as_float(p0[j].x << 16) + ti.w1 * __uint_as_float(p1[j].x << 16); f.y = ti.w0 * __uint_as_float(p0[j].x & 0xffff0000u) + ti.w1 * __uint_as_float(p1[j].x & 0xffff0000u);
        f.z = ti.w0 * __uint_as_float(p0[j].y << 16) + ti.w1 * __uint_as_float(p1[j].y << 16); f.w = ti.w0 * __uint_as_float(p0[j].y & 0xffff0000u) + ti.w1 * __uint_as_float(p1[j].y & 0xffff0000u);
        x[j] = x[j] + G * f; ((f32x4*)xr)[c4] = x[j]; }
    if (l < DEPTH - 1) modnorm_regs(x, a->in[I_N1G] + (l + 1) * DM, modp(a, l + 1, row, 1), modp(a, l + 1, row, 0), H + (size_t)row * DM, lane);
}
DEV void phase_comb(KArgsP a, const Fr& F, int l) {
    const int ntok = l < DEPTH - 1 ? NTOK : SEQ;
    const bf16_t* Y = (const bf16_t*)(a->ws + WS_P); const TokInfo* TI = (const TokInfo*)(a->ws + WS_TOK); bf16_t* H = (bf16_t*)(a->ws + WS_H);
    for (int row = F.gw; row < ntok; row += 2 * F.NGW) {
        const int rowb = row + F.NGW; const bool hb = rowb < ntok;
        TokInfo ta, tb; f32x4 xa[4], xb[4]; u32x2 pa0[4], pa1[4], pb0[4], pb1[4];
        comb_load(a, row, Y, TI, ta, xa, pa0, pa1, F.lane); comb_load(a, hb ? rowb : row, Y, TI, tb, xb, pb0, pb1, F.lane);
        comb_finish(a, l, row, ta, xa, pa0, pa1, H, F.lane);
        if (hb) comb_finish(a, l, rowb, tb, xb, pb0, pb1, H, F.lane);
    }
}

#define XB_TMO      128
#define XB_XCNT(j)  (256  + 64 * (j))
#define XB_XSUB(j)  (1280 + 64 * (j))
#define XB_XGEN(j)  (2304 + 64 * (j))
#define XB_TOP      3328
#define XB_TOPGEN   3392
#define XCD_BAR_WORDS 3456
#define XB_SPIN_CAP (1u << 22)
DEV unsigned xb_ld(unsigned* p)              { return __hip_atomic_load(p, __ATOMIC_RELAXED, __HIP_MEMORY_SCOPE_AGENT); }
DEV unsigned xb_add(unsigned* p, unsigned v) { return __hip_atomic_fetch_add(p, v, __ATOMIC_RELAXED, __HIP_MEMORY_SCOPE_AGENT); }
DEV unsigned xb_xcc_id() { return (unsigned)__builtin_amdgcn_s_getreg((3 << 11) | 20) & 0xFu; }
#define XB_SPIN(cond, bar) do { unsigned _sp = 0; while (cond) { __builtin_amdgcn_s_sleep(1); \
    if ((++_sp & 255u) == 0u) { if (xb_ld(&(bar)[XB_TMO])) break; if (_sp > XB_SPIN_CAP) { atomicAdd(&(bar)[XB_TMO], 1u); break; } } } } while (0)
struct XcdBarrier { unsigned* bar; unsigned x; volatile LAS unsigned* st; };
DEV XcdBarrier xcd_barrier_post(unsigned* bar, volatile LAS unsigned* st, bool leader) {
    XcdBarrier b; b.bar = bar; b.x = xb_xcc_id(); b.st = st;
    if (leader) (void)xb_add(&bar[XB_XCNT(b.x)], 1u);
    return b;
}
DEV void xcd_barrier_complete(unsigned* bar, unsigned x, unsigned& nloc, unsigned& nx) {
    const unsigned G = GRID;
    unsigned sum, cnt, mine, sp = 0u;
    for (;;) {
        sum = 0u; cnt = 0u; mine = 0u;
#pragma unroll
        for (unsigned j = 0; j < 16; ++j) { const unsigned c = xb_ld(&bar[XB_XCNT(j)]); sum += c; cnt += (c > 0u) ? 1u : 0u; mine = (j == x) ? c : mine; }
        if (sum == G) break;
        __builtin_amdgcn_s_sleep(1);
        if ((++sp & 255u) == 0u) { if (xb_ld(&bar[XB_TMO])) break; if (sp > XB_SPIN_CAP) { atomicAdd(&bar[XB_TMO], 1u); break; } }
    }
    nloc = mine > 0u ? mine : 1u; nx = cnt > 0u ? cnt : 1u;
}
DEV void xcd_barrier(const XcdBarrier& b, bool leader) {
    asm volatile("s_waitcnt vmcnt(0)" ::: "memory");
    __syncthreads();
    if (leader) {
        unsigned* bar = b.bar;
        __builtin_amdgcn_s_waitcnt(0);
        unsigned nloc = b.st[0], nx = b.st[1];
        if (nloc == 0u) { xcd_barrier_complete(bar, b.x, nloc, nx); b.st[0] = nloc; b.st[1] = nx; }
        const unsigned old = xb_add(&bar[XB_XSUB(b.x)], 1u);
        const unsigned gen = old / nloc;
        if (old + 1u == (gen + 1u) * nloc) {
            __builtin_amdgcn_fence(__ATOMIC_RELEASE, "agent");
            asm volatile("s_waitcnt vmcnt(0)" ::: "memory");
            const unsigned og = xb_add(&bar[XB_TOP], 1u);
            const unsigned tg = og / nx;
            if (og + 1u == (tg + 1u) * nx) xb_add(&bar[XB_TOPGEN], 1u);
            else XB_SPIN(xb_ld(&bar[XB_TOPGEN]) == tg, bar);
            __builtin_amdgcn_fence(__ATOMIC_ACQUIRE, "agent");
            xb_add(&bar[XB_XGEN(b.x)], 1u);
            asm volatile("s_waitcnt vmcnt(0)" ::: "memory");
        } else {
            XB_SPIN(xb_ld(&bar[XB_XGEN(b.x)]) == gen, bar);
            __builtin_amdgcn_fence(__ATOMIC_ACQUIRE, "agent");
            asm volatile("s_waitcnt vmcnt(0)" ::: "memory");
        }
    }
    __syncthreads();
}

constexpr int NPH = 2 + 9 * DEPTH;
__global__ void __launch_bounds__(NTHR, 2) mega(KArgs a_unused) {
    extern __shared__ __attribute__((aligned(16))) unsigned char lds_raw[];
#define FRAME() Fr F; { int l_ = lane_id_fresh(); int w_ = wave_s; asm volatile("" : "+s"(w_)); int b_ = blockIdx.x; asm volatile("" : "+s"(b_)); \
      F.tid = w_ * 64 + l_; F.lane = l_; F.wave = w_; F.bid = b_; F.gw = F.bid * NWAVES + F.wave; F.lds = (LAS unsigned char*)lds_raw; }
#define IN(k) (lo <= (k) && (k) < hi)
    const int wave_s = __builtin_amdgcn_readfirstlane((int)threadIdx.x >> 6);
#if N_LAUNCHES == 1 && !defined(DBG_STOP)
    constexpr int lo = 0, hi = NPH;
#else
    int lo, hi; { KArgsP a = kargs(); lo = a->ph_lo; hi = a->ph_hi; }
#endif
    XcdBarrier bar;
    { KArgsP a = kargs();
      volatile LAS unsigned* st = (volatile LAS unsigned*)((LAS unsigned char*)lds_raw + LDS_BYTES - 64);
      const int l0_ = lane_id_fresh();
      if (wave_s == 0 && l0_ < 16) st[l0_] = 0u;
      __syncthreads();
      bar = xcd_barrier_post((unsigned*)(a->ws + WS_CTL) + 4096, st, wave_s == 0 && l0_ == 0); }
#define SEAM(k) do { if ((k) + 1 < hi) xcd_barrier(bar, wave_s == 0 && lane_id_fresh() == 0); } while (0)
    if (IN(0)) REPS(100) { FRAME(); phase_pro_a(kargs(), F); SEAM(0); }
    if (IN(1)) REPS(101) { FRAME(); phase_pro_b(kargs(), F); SEAM(1); }
    for (int l = 0; l < DEPTH; ++l) {
        const int pb = 2 + 9 * l, i = l >> 1; const bool even = (l & 1) == 0;
        if (IN(pb + 0)) REPS(0) { FRAME(); KArgsP a = kargs();
            const bf16_t* Hh = (const bf16_t*)(a->ws + WS_H); bf16_t* Pp = (bf16_t*)(a->ws + WS_P);
            const bf16_t* Wt = even ? (const bf16_t*)(a->ws + WS_WEVIN) + (size_t)i * EV_IN * DM : (const bf16_t*)(a->ws + WS_WODIN) + (size_t)i * OD_IN * DM;
            const int N = even ? EV_IN : OD_IN;
            { pg8::Gemm g{Hh, Wt, SEQ, N, DM}; pg8::StaticOrder S; S.init(SEQ, N, F.G, F.bid); pg8::EpiBf16 E{Pp, N};
              pg8::gemm_phase<pg8::EpiBf16, pg8::StaticOrder, true, true>(F.lds, g, S, E, F.tid); }
            gemm_simple(Hh + (size_t)SEQ * DM, Wt, NCTX, N, DM, EpiP{Pp, N}, F, SEQ);
            SEAM(pb + 0); }
        if (IN(pb + 1)) { FRAME(); if (even) phase_pre_even(kargs(), F, i); else phase_pre_odd(kargs(), F, i); SEAM(pb + 1); }
        if (IN(pb + 2)) REPS(2) {
            { FRAME(); if (even) phase_mix_even(kargs(), F, i); else phase_mix_odd(kargs(), F, i); }
            { FRAME(); if (even) phase_mix_even_b(kargs(), F, i); else phase_mix_odd_b(kargs(), F, i); }
            SEAM(pb + 2); }
        if (IN(pb + 3)) { FRAME(); KArgsP a = kargs();
            const bf16_t* Mm = (const bf16_t*)(a->ws + WS_MX); const bf16_t* Wt = (const bf16_t*)(a->ws + (even ? WS_WEVOUT : WS_WODOUT)) + (size_t)i * DM * DM;
            { pg8::Gemm g{Mm, Wt, SEQ, DM, DM}; pg8::StaticOrder S; S.init(SEQ, DM, F.G, F.bid); pg8::EpiResF32 E{xrow_in(a, l, 0), a->out, modp(a, l, 0, 2)};
              pg8::gemm_phase<pg8::EpiResF32, pg8::StaticOrder, true, true>(F.lds, g, S, E, F.tid); }
            gemm_simple(Mm + (size_t)SEQ * DM, Wt, NCTX, DM, DM, EpiRes{a, l}, F, SEQ);
            SEAM(pb + 3); }
        if (IN(pb + 4)) REPS(4) { FRAME(); phase_norm2(kargs(), F, l); SEAM(pb + 4); }
        if (IN(pb + 5)) REPS(5) { FRAME(); phase_gather(kargs(), F, l); SEAM(pb + 5); }
        if (IN(pb + 6)) REPS(6) { FRAME(); KArgsP a = kargs(); const int* blk = (const int*)(a->ws + WS_BLK);
            const int nblk = __builtin_amdgcn_readfirstlane((int)__hip_atomic_load((const unsigned*)blk, __ATOMIC_RELAXED, __HIP_MEMORY_SCOPE_AGENT));
            pg8::Gemm g{(const bf16_t*)(a->ws + WS_BUF), (const bf16_t*)(a->ws + WS_WGU) + (size_t)l * 16 * 1024 * 1024, nblk * 256, 1024, DM};
            pg8::GroupedOrder S{nblk * 4, F.G, F.bid, 4, blk, 2l * 1024 * 1024}; pg8::EpiGU E{(bf16_t*)(a->ws + WS_ACT)};
            pg8::gemm_phase<pg8::EpiGU, pg8::GroupedOrder, true, true>(F.lds, g, S, E, F.tid);
            SEAM(pb + 6); }
        if (IN(pb + 7)) REPS(7) { FRAME(); KArgsP a = kargs(); const int* blk = (const int*)(a->ws + WS_BLK);
            const int nblk = __builtin_amdgcn_readfirstlane((int)__hip_atomic_load((const unsigned*)blk, __ATOMIC_RELAXED, __HIP_MEMORY_SCOPE_AGENT));
            pg8::Gemm g{(const bf16_t*)(a->ws + WS_ACT), (const bf16_t*)(a->ws + WS_WDN) + (size_t)l * 16 * 1024 * 512, nblk * 256, 1024, DEXP};
            pg8::GroupedOrder S{nblk * 4, F.G, F.bid, 4, blk, 1l * 1024 * 1024}; pg8::EpiBf16 E{(bf16_t*)(a->ws + WS_P), DM};
            pg8::gemm_phase<pg8::EpiBf16, pg8::GroupedOrder, true, true>(F.lds, g, S, E, F.tid);
            SEAM(pb + 7); }
        if (IN(pb + 8)) { FRAME(); phase_comb(kargs(), F, l); SEAM(pb + 8); }
    }
#undef IN
#ifdef DBG_STOP
    { FRAME(); KArgsP a = kargs(); xcd_barrier(bar, F.tid == 0); const bf16_t* src = (const bf16_t*)(a->ws + DBG_SRC); float* o = a->out;
      for (size_t i = (size_t)F.bid * NTHR + F.tid; i < (size_t)SEQ * DM; i += (size_t)F.G * NTHR) o[i] = bf2f(src[i]); }
#endif
}

extern "C" void kernel_launch(void* const* d_in, const int* in_sizes, int n_in, void* d_out, int out_size, void* d_ws, size_t ws_size, hipStream_t stream) {
    static int grid = 0;
    if (grid == 0) {
        if (n_in != 29 || out_size != SEQ * DM || ws_size < WS_END) { fprintf(stderr, "kernel_launch: unexpected problem (n_in %d, out %d, ws %zu)\n", n_in, out_size, ws_size); grid = -1; return; }
        int dev = 0, cus = 0, per_cu = 0;
        if (hipGetDevice(&dev) != hipSuccess || hipDeviceGetAttribute(&cus, hipDeviceAttributeMultiprocessorCount, dev) != hipSuccess) { grid = -1; return; }
        if (hipFuncSetAttribute((const void*)mega, hipFuncAttributeMaxDynamicSharedMemorySize, LDS_BYTES) != hipSuccess) { fprintf(stderr, "kernel_launch: hipFuncSetAttribute failed\n"); grid = -1; return; }
        if (hipOccupancyMaxActiveBlocksPerMultiprocessor(&per_cu, (const void*)mega, NTHR, LDS_BYTES) != hipSuccess || per_cu < 1) { fprintf(stderr, "kernel_launch: occupancy query says %d\n", per_cu); (void)hipGetLastError(); }
        if (cus < GRID) { fprintf(stderr, "kernel_launch: %d CUs, the kernel needs %d resident workgroups\n", cus, GRID); grid = -1; return; }
        grid = GRID;
    }
    if (grid < 0) return;
    KArgs a{};
    for (int i = 0; i < 29; ++i) a.in[i] = (const float*)d_in[i];
    a.out = (float*)d_out; a.ws = (unsigned char*)d_ws;
    (void)hipMemsetAsync((char*)d_ws + WS_CTL, 0, CTL_BYTES, stream);
#if N_LAUNCHES == 1
    a.ph_lo = 0; a.ph_hi = NPH; hipLaunchKernelGGL(mega, dim3(grid), dim3(NTHR), LDS_BYTES, stream, a);
#else
    for (int ph = 0; ph < NPH; ++ph) { a.ph_lo = ph; a.ph_hi = ph + 1; hipLaunchKernelGGL(mega, dim3(grid), dim3(NTHR), LDS_BYTES, stream, a); }
#endif
}
```
